# Optimizing an MI355X kernel written in HIP

```python
import math
import jax, jax.numpy as jnp
from jax import lax
import numpy as np

D_MODEL = 2048
BATCH = 1
SEQ = 16384
DEPTH = 1

GRID_W = 64
CTX_LEN = 256
HEAD_DIM = 128
N_HEADS = 8
N_KV_HEADS = 2
GROUP = N_HEADS // N_KV_HEADS
WINDOW = 128
BLK = 128
Q_DIM = N_HEADS * HEAD_DIM
KV_DIM = N_KV_HEADS * HEAD_DIM
N_FGROUPS = 4
FG = 256
F_DIM = N_FGROUPS * FG
D_IN = Q_DIM + 2 * KV_DIM + F_DIM
D_MIX = Q_DIM + F_DIM
N_EXPERTS = 16
CAP_FACTOR = 2
EXPERT_FF = 1024
ROPE_THETA = 10000.0
RMS_EPS = 1e-6
NEG_INF = -1e30

kernel_name = "hybrid_swa_fnet_ec_moe_dit"


def _rmsnorm(x, g):
    xf = x.astype(jnp.float32)
    y = xf * lax.rsqrt(jnp.mean(xf * xf, axis=-1, keepdims=True) + RMS_EPS)
    return (y * g.astype(jnp.float32)).astype(x.dtype)


def _modulate(h, shift, scale):
    return h * (1 + scale) + shift


def _axial_rope_tables(n, dtype):
    rows = n // GRID_W
    row = jnp.repeat(jnp.arange(rows, dtype=jnp.float32), GRID_W)
    col = jnp.tile(jnp.arange(GRID_W, dtype=jnp.float32), rows)
    quarter = HEAD_DIM // 4
    freqs = ROPE_THETA ** (-jnp.arange(quarter, dtype=jnp.float32) / quarter)
    ar = row[:, None] * freqs[None, :]
    ac = col[:, None] * freqs[None, :]
    ang = jnp.concatenate([ar, ar, ac, ac], axis=-1)
    return jnp.cos(ang).astype(dtype), jnp.sin(ang).astype(dtype)


def _apply_rope(x, cos, sin):
    shp = x.shape
    xr = x.reshape(shp[:-1] + (2, 2, HEAD_DIM // 4))
    rot = jnp.stack([-xr[..., 1, :], xr[..., 0, :]], axis=-2).reshape(shp)
    return x * cos[None, :, None, :] + rot * sin[None, :, None, :]


def _softmax_with_sink(s, sink):
    s = s.astype(jnp.float32)
    sk = jnp.broadcast_to(sink.astype(jnp.float32), s.shape[:-1] + (1,))
    p = jax.nn.softmax(jnp.concatenate([s, sk], axis=-1), axis=-1)
    return p[..., :-1]


def _split_proj(p):
    q = p[..., :Q_DIM]
    k = p[..., Q_DIM:Q_DIM + KV_DIM]
    v = p[..., Q_DIM + KV_DIM:Q_DIM + 2 * KV_DIM]
    u = p[..., Q_DIM + 2 * KV_DIM:]
    b, n = p.shape[0], p.shape[1]
    return (q.reshape(b, n, N_HEADS, HEAD_DIM), k.reshape(b, n, N_KV_HEADS, HEAD_DIM),
            v.reshape(b, n, N_KV_HEADS, HEAD_DIM), u)


def _windowed_attention(q, k, v, k_ctx, v_ctx, sink):
    b, n = q.shape[0], q.shape[1]
    nb = n // BLK
    scale = 1.0 / math.sqrt(HEAD_DIM)
    qb = q.reshape(b, nb, BLK, N_KV_HEADS, GROUP, HEAD_DIM)

    def band(t):
        tb = jnp.pad(t.reshape(b, nb, BLK, N_KV_HEADS, HEAD_DIM),
                     ((0, 0), (1, 1), (0, 0), (0, 0), (0, 0)))
        return jnp.concatenate([tb[:, :-2], tb[:, 1:-1], tb[:, 2:]], axis=2)

    kw, vw = band(k), band(v)
    blk = jnp.arange(nb)[:, None, None]
    qpos = blk * BLK + jnp.arange(BLK)[None, :, None]
    kpos = blk * BLK - BLK + jnp.arange(3 * BLK)[None, None, :]
    valid = (jnp.abs(qpos - kpos) <= WINDOW) & (kpos >= 0) & (kpos < n)

    s_loc = jnp.einsum('bnqhgd,bnkhd->bhgnqk', qb, kw).astype(jnp.float32) * scale
    s_loc = jnp.where(valid, s_loc, NEG_INF)
    s_ctx = jnp.einsum('bnqhgd,bmhd->bhgnqm', qb, k_ctx).astype(jnp.float32) * scale
    sink_b = sink.reshape(N_KV_HEADS, GROUP)[None, :, :, None, None, None]
    p = _softmax_with_sink(jnp.concatenate([s_loc, s_ctx], axis=-1), sink_b).astype(v.dtype)
    p_loc, p_ctx = p[..., :3 * BLK], p[..., 3 * BLK:]
    o = (jnp.einsum('bhgnqk,bnkhd->bnqhgd', p_loc, vw)
         + jnp.einsum('bhgnqm,bmhd->bnqhgd', p_ctx, v_ctx))
    return o.reshape(b, n, Q_DIM)


def _context_attention(q, k, v, sink):
    b, m = q.shape[0], q.shape[1]
    scale = 1.0 / math.sqrt(HEAD_DIM)
    qg = q.reshape(b, m, N_KV_HEADS, GROUP, HEAD_DIM)
    s = jnp.einsum('bqhgd,bkhd->bhgqk', qg, k).astype(jnp.float32) * scale
    sink_b = sink.reshape(N_KV_HEADS, GROUP)[None, :, :, None, None]
    p = _softmax_with_sink(s, sink_b).astype(v.dtype)
    return jnp.einsum('bhgqk,bkhd->bqhgd', p, v).reshape(b, m, Q_DIM)


def _fourier_mix(u, w_f):
    b, n = u.shape[0], u.shape[1]
    ug = u.reshape(b, n, N_FGROUPS, FG).astype(jnp.float32)
    y = jnp.fft.fft2(ug, axes=(1, 3), norm='ortho').real.astype(u.dtype)
    return jnp.einsum('bngc,gcd->bngd', y, w_f).reshape(b, n, F_DIM)


def _mixer(h_x, h_c, w_in, w_out, w_f, sink, with_ctx_out):
    qx, kx, vx, ux = _split_proj(h_x @ w_in)
    qc, kc, vc, uc = _split_proj(h_c @ w_in)
    cos, sin = _axial_rope_tables(h_x.shape[1], h_x.dtype)
    qx, kx = _apply_rope(qx, cos, sin), _apply_rope(kx, cos, sin)
    ax = _windowed_attention(qx, kx, vx, kc, vc, sink)
    fx = _fourier_mix(ux, w_f)
    out_x = jnp.concatenate([ax, fx], axis=-1) @ w_out
    if not with_ctx_out:
        return out_x, None
    ac = _context_attention(qc, kc, vc, sink)
    fc = _fourier_mix(uc, w_f)
    out_c = jnp.concatenate([ac, fc], axis=-1) @ w_out
    return out_x, out_c


def _expert_choice_ffn(h, w_router, w_gate, w_up, w_down):
    b, n, d = h.shape
    cap = max(1, CAP_FACTOR * n // N_EXPERTS)
    logits = jnp.einsum('bnd,de->ben', h, w_router).astype(jnp.float32)
    aff = jax.nn.softmax(logits, axis=1)
    gates, idx = lax.top_k(aff, cap)
    xs = jax.vmap(lambda hb, ib: hb[ib])(h, idx)
    g = jnp.einsum('becd,edf->becf', xs, w_gate)
    u = jnp.einsum('becd,edf->becf', xs, w_up)
    y = jnp.einsum('becf,efd->becd', jax.nn.silu(g) * u, w_down)
    y = y * gates[..., None].astype(y.dtype)

    def combine(ib, yb):
        return jnp.zeros((n, d), yb.dtype).at[ib.reshape(-1)].add(yb.reshape(-1, d))

    return jax.vmap(combine)(idx, y)


def setup_inputs(seed: int = 0) -> dict:
    key = jax.random.key(seed)
    ks = jax.random.split(key, 20)
    f32 = jnp.float32
    L, D = DEPTH, D_MODEL
    nrm = lambda k, shp, s: jax.random.normal(k, shp, f32) * s
    return {
        'x': nrm(ks[0], (BATCH, SEQ, D), 1.0),
        'c': nrm(ks[1], (BATCH, D), 1.0),
        'ctx': nrm(ks[2], (BATCH, CTX_LEN, D), 1.0),
        'c_ctx': nrm(ks[3], (D,), 1.0),
        'w_mod': nrm(ks[4], (L, D, 6 * D), 0.5 * D ** -0.5),
        'b_mod': nrm(ks[5], (L, 6 * D), 0.02),
        'norm_mix': 1.0 + nrm(ks[6], (L, D), 0.05),
        'w_in': nrm(ks[7], (L, D, D_IN), D ** -0.5),
        'sink': nrm(ks[8], (L, N_HEADS), 0.5),
        'w_fourier': nrm(ks[9], (L, N_FGROUPS, FG, FG), FG ** -0.5),
        'w_out': nrm(ks[10], (L, D_MIX, D), D_MIX ** -0.5),
        'norm_ffn': 1.0 + nrm(ks[11], (L, D), 0.05),
        'w_router': nrm(ks[12], (L, D, N_EXPERTS), D ** -0.5),
        'w_gate': nrm(ks[13], (L, N_EXPERTS, D, EXPERT_FF), D ** -0.5),
        'w_up': nrm(ks[14], (L, N_EXPERTS, D, EXPERT_FF), D ** -0.5),
        'w_down': nrm(ks[15], (L, N_EXPERTS, EXPERT_FF, D), EXPERT_FF ** -0.5),
        'norm_final': 1.0 + nrm(ks[16], (D,), 0.05),
    }


def reference(x, c, ctx, c_ctx, w_mod, b_mod, norm_mix, w_in, sink, w_fourier, w_out,
              norm_ffn, w_router, w_gate, w_up, w_down, norm_final):
    b = x.shape[0]
    for l in range(DEPTH):
        last = l == DEPTH - 1
        mod_x = (jax.nn.silu(c) @ w_mod[l] + b_mod[l]).reshape(b, 6, 1, D_MODEL)
        mod_c = (jax.nn.silu(c_ctx) @ w_mod[l] + b_mod[l]).reshape(6, D_MODEL)

        h_x = _modulate(_rmsnorm(x, norm_mix[l]), mod_x[:, 0], mod_x[:, 1])
        h_c = _modulate(_rmsnorm(ctx, norm_mix[l]), mod_c[0], mod_c[1])
        out_x, out_c = _mixer(h_x, h_c, w_in[l], w_out[l], w_fourier[l], sink[l], not last)
        x = x + mod_x[:, 2] * out_x

        g_x = _modulate(_rmsnorm(x, norm_ffn[l]), mod_x[:, 3], mod_x[:, 4])
        x = x + mod_x[:, 5] * _expert_choice_ffn(g_x, w_router[l], w_gate[l], w_up[l], w_down[l])

        if not last:
            ctx = ctx + mod_c[2] * out_c
            g_c = _modulate(_rmsnorm(ctx, norm_ffn[l]), mod_c[3], mod_c[4])
            ctx = ctx + mod_c[5] * _expert_choice_ffn(g_c, w_router[l], w_gate[l], w_up[l], w_down[l])
    return _rmsnorm(x, norm_final)
```

```cpp
#include <hip/hip_runtime.h>
#include <hip/hip_cooperative_groups.h>
#include <cstdio>
#include <cstdint>
namespace cg = cooperative_groups;

#ifndef SELF_CHECK
#define SELF_CHECK 0
#endif

#define LAS __attribute__((address_space(3)))
#define GAS __attribute__((address_space(1)))
typedef unsigned short bf16_t;
typedef short bf16x8 __attribute__((ext_vector_type(8)));
typedef short s16x4 __attribute__((ext_vector_type(4)));
typedef float f32x2 __attribute__((ext_vector_type(2)));
typedef float f32x4 __attribute__((ext_vector_type(4)));
typedef float f32x16 __attribute__((ext_vector_type(16)));
typedef unsigned u32x2 __attribute__((ext_vector_type(2)));
typedef unsigned u32x4 __attribute__((ext_vector_type(4)));
typedef __bf16 bf16x2_t __attribute__((ext_vector_type(2)));

constexpr int DM = 2048, SEQ = 16384, CTXL = 256, NTOK = SEQ + CTXL;
constexpr int DIN = 2560, QD = 1024, KVD = 256, FD = 1024, NHEAD = 8, HD = 128;
constexpr int NE = 16, CAP = 2048, FF = 1024, NMOD = 6 * DM;
constexpr float RMS_EPS = 1e-6f;
constexpr float LOG2E = 1.4426950408889634f;
constexpr float QSCALE = 0.08838834764831845f * LOG2E;

constexpr size_t MiB = 1u << 20;
constexpr size_t WS_CTL = 0, CTL_BYTES = 1 * MiB;
constexpr size_t WS_MODP = 1 * MiB;
constexpr size_t WS_MODF = 3 * MiB;
constexpr size_t WS_F1 = 3 * MiB + 256 * 1024;
constexpr size_t WS_G2 = 3 * MiB + 512 * 1024;
constexpr size_t WS_TWC = 4 * MiB, WS_TWS = 4 * MiB + 64 * 1024;
constexpr size_t WS_ROPEC = 4 * MiB + 128 * 1024, WS_ROPES = 4 * MiB + 192 * 1024;
constexpr size_t WS_MGT = 5 * MiB;
constexpr size_t WS_AFF = 6 * MiB;
constexpr size_t WS_IDX = 7 * MiB;
constexpr size_t WS_GATE = 7 * MiB + 128 * 1024;
constexpr size_t WS_SLOT = 8 * MiB;
constexpr size_t WS_DBG = 9 * MiB;
constexpr size_t WS_WINT = 16 * MiB;
constexpr size_t WS_WOT = 27 * MiB;
constexpr size_t WS_WGU = 36 * MiB;
constexpr size_t WS_WD = 164 * MiB;
constexpr size_t WS_RA = 228 * MiB;
constexpr size_t WS_RB = 358 * MiB;
constexpr size_t WS_RC = 486 * MiB;
constexpr size_t WS_END = 550 * MiB;
constexpr size_t RA_HN = WS_RA, RA_HP = WS_RA + 65 * MiB, RA_T = WS_RA, RA_PQ = WS_RA + 64 * MiB, RA_GX = WS_RA, RA_HMID = WS_RA + 64 * MiB;
constexpr size_t RB_Q = WS_RB, RB_K = WS_RB + 32 * MiB, RB_VT = WS_RB + 41 * MiB, RB_UX = WS_RB + 50 * MiB, RB_XS = WS_RB, RB_SLAB = WS_RB;

constexpr int LDS_BYTES = 147456;
constexpr int NWAVES = 8, NTHREADS = 512;

struct Params {
    const float *x, *c, *ctx, *c_ctx, *w_mod, *b_mod, *norm_mix, *w_in, *sink, *w_f, *w_out, *norm_ffn, *w_router, *w_gate, *w_up, *w_down, *norm_final;
    float* out; unsigned char* ws;
};

__device__ __forceinline__ unsigned pk2(float lo, float hi) { f32x2 v = {lo, hi}; bf16x2_t b = __builtin_convertvector(v, bf16x2_t); return __builtin_bit_cast(unsigned, b); }
__device__ __forceinline__ bf16_t f2bf(float f) { unsigned u = __builtin_bit_cast(unsigned, f); return (bf16_t)((u + 0x7fffu + ((u >> 16) & 1u)) >> 16); }
__device__ __forceinline__ float bf2f(bf16_t b) { return __builtin_bit_cast(float, ((unsigned)b) << 16); }
__device__ __forceinline__ u32x2 pk4(f32x4 v) { u32x2 r; r.x = pk2(v[0], v[1]); r.y = pk2(v[2], v[3]); return r; }
__device__ __forceinline__ float wave_sum(float v) {
#pragma unroll
    for (int o = 1; o < 64; o <<= 1) v += __shfl_xor(v, o);
    return v;
}
__device__ __forceinline__ float siluf(float v) { return v / (1.0f + __expf(-v)); }
#define LDS_WAIT() asm volatile("s_waitcnt lgkmcnt(0)" ::: "memory")

namespace pg8 {
constexpr int BM = 256, BK = 64, HALF = 128, HTB = HALF * BK * 2, STAGE_BYTES = 8 * HTB;
__device__ __forceinline__ int lds_byte(int r, int c) { const int st = (r >> 4) * 2 + (c >> 5), rr = r & 15, cc = c & 31, ob = rr * 64 + cc * 2; return st * 1024 + (ob ^ (((ob >> 9) & 1) << 5)); }
__device__ __forceinline__ void stage_rc(int b, int& R, int& C) { const int st = b / 1024, sb = b % 1024, swz = sb ^ (((sb >> 9) & 1) << 5); R = (st >> 1) * 16 + swz / 64; C = (st & 1) * 32 + (swz % 64) / 2; }

struct GUnit { const char* A; const char* B; int pm, pn, z; };

template <class Epi, class Sched>
__device__ __forceinline__ void gemm_phase(LAS unsigned char* lds, const int K, const int lda, const int ldb, const Sched& S, const Epi& E) {
    int tid_ = threadIdx.x; asm volatile("" : "+v"(tid_));
    const int tid = tid_, wid = __builtin_amdgcn_readfirstlane(tid >> 6), lane = tid & 63, wr = wid >> 2, wc = wid & 3, fr = lane & 15, fq = lane >> 4;
    const int nt = K / BK;
    unsigned voffA[2], voffB[2];
#pragma unroll
    for (int i = 0; i < 2; ++i) { int R, C; stage_rc(tid * 16 + i * 8192, R, C); voffA[i] = (unsigned)(R * lda + C) * 2u; voffB[i] = (unsigned)(R * ldb + C) * 2u; }
    const size_t hsA = (size_t)HALF * lda * 2, hsB = (size_t)HALF * ldb * 2;
    const size_t kstep = (size_t)(BK * 2);
    const unsigned ldsw = (unsigned)wid * 1024u;
    const int aoff = lds_byte(wr * 64 + fr, fq * 8), boff = lds_byte(wc * 32 + fr, fq * 8);
#define PG8_SA(b, h) (((b) * 2 + (h)) * HTB)
#define PG8_SB(b, h) ((4 + (b) * 2 + (h)) * HTB)
#define PG8_STAGE(bufoff, gbase, voff) do { _Pragma("unroll") for (int _i = 0; _i < 2; ++_i) \
        __builtin_amdgcn_global_load_lds((const unsigned*)((const char*)(gbase) + (voff)[_i]), (LAS unsigned*)(lds + (bufoff) + ldsw + _i * 8192), 16, 0, 0); } while (0)
#define PG8_LDA(dst, b, h) do { _Pragma("unroll") for (int m = 0; m < 4; ++m) _Pragma("unroll") for (int k = 0; k < 2; ++k) dst[m][k] = *(const LAS bf16x8*)(lds + PG8_SA(b, h) + aoff + m * 2048 + k * 1024); } while (0)
#define PG8_LDB(dst, b, h) do { _Pragma("unroll") for (int n = 0; n < 2; ++n) _Pragma("unroll") for (int k = 0; k < 2; ++k) dst[n][k] = *(const LAS bf16x8*)(lds + PG8_SB(b, h) + boff + n * 2048 + k * 1024); } while (0)
#define PG8_MMA(ai, bj, At, Bt) do { __builtin_amdgcn_s_setprio(1); _Pragma("unroll") for (int m = 0; m < 4; ++m) _Pragma("unroll") for (int n = 0; n < 2; ++n) _Pragma("unroll") for (int k = 0; k < 2; ++k) \
        acc[ai][bj][m][n] = __builtin_amdgcn_mfma_f32_16x16x32_bf16(Bt[n][k], At[m][k], acc[ai][bj][m][n], 0, 0, 0); __builtin_amdgcn_s_setprio(0); } while (0)
#define PG8_WAIT_V(n) asm volatile("s_waitcnt vmcnt(" #n ")" ::: "memory")
#define PG8_WAIT_L(n) asm volatile("s_waitcnt lgkmcnt(" #n ")" ::: "memory")
#define PG8_BAR __builtin_amdgcn_s_barrier()
#define PG8_SCHED __builtin_amdgcn_sched_barrier(0)
    GUnit cur, nxt; int ui = 0;
    if (!S.next(0, cur)) return;
    asm volatile("" : "+s"(cur.A), "+s"(cur.B));
    f32x4 acc[2][2][4][2];
#pragma unroll
    for (int a = 0; a < 2; ++a)
#pragma unroll
        for (int b = 0; b < 2; ++b)
#pragma unroll
            for (int m = 0; m < 4; ++m)
#pragma unroll
                for (int n = 0; n < 2; ++n) acc[a][b][m][n] = (f32x4){0.f, 0.f, 0.f, 0.f};
    bf16x8 At[4][2], B0[2][2], B1[2][2];
    const char* cA = cur.A; const char* cB = cur.B;
    PG8_STAGE(PG8_SB(0, 0), cB, voffB); PG8_STAGE(PG8_SB(0, 1), cB + hsB, voffB); PG8_STAGE(PG8_SA(0, 0), cA, voffA); PG8_STAGE(PG8_SA(0, 1), cA + hsA, voffA);
    if (wr == 1) PG8_BAR;
    PG8_WAIT_V(2); PG8_BAR;
    PG8_STAGE(PG8_SB(1, 0), cB + kstep, voffB); PG8_STAGE(PG8_SA(1, 0), cA + kstep, voffA); PG8_STAGE(PG8_SB(1, 1), cB + hsB + kstep, voffB);
    PG8_WAIT_V(6); PG8_BAR;
    for (;;) {
        const bool has_next = S.next(ui + 1, nxt);
        if (has_next) asm volatile("" : "+s"(nxt.A), "+s"(nxt.B));
        const char* nA = has_next ? nxt.A : cA; const char* nB = has_next ? nxt.B : cB;
        for (int t = 0; t < nt; t += 2) {
            const bool last = (t == nt - 2);
            const char* a1 = cA + (size_t)(t + 1) * kstep;
            const char* a2_ = last ? nA : cA + (size_t)(t + 2) * kstep; const char* b2_ = last ? nB : cB + (size_t)(t + 2) * kstep;
            const char* a2 = a2_; const char* b2 = b2_; const char* a3 = a2 + kstep; const char* b3 = b2 + kstep;
            asm volatile("" : "+s"(a1), "+s"(a2), "+s"(b2), "+s"(a3), "+s"(b3));
            PG8_LDB(B0, 0, 0); PG8_LDB(B1, 0, 1); PG8_SCHED; PG8_LDA(At, 0, 0); PG8_STAGE(PG8_SA(1, 1), a1 + hsA, voffA);
            PG8_WAIT_V(8); PG8_WAIT_L(0); PG8_BAR; PG8_MMA(0, 0, At, B0); PG8_MMA(0, 1, At, B1); PG8_BAR; PG8_SCHED;
            PG8_LDA(At, 0, 1); PG8_STAGE(PG8_SB(0, 0), b2, voffB); PG8_STAGE(PG8_SB(0, 1), b2 + hsB, voffB); PG8_STAGE(PG8_SA(0, 0), a2, voffA);
            PG8_WAIT_V(8); PG8_WAIT_L(0); PG8_BAR; PG8_MMA(1, 0, At, B0); PG8_MMA(1, 1, At, B1); PG8_BAR; PG8_SCHED;
            PG8_LDB(B0, 1, 0); PG8_LDB(B1, 1, 1); PG8_SCHED; PG8_LDA(At, 1, 0); PG8_STAGE(PG8_SA(0, 1), a2 + hsA, voffA);
            PG8_WAIT_V(8); PG8_WAIT_L(0); PG8_BAR; PG8_MMA(0, 0, At, B0); PG8_MMA(0, 1, At, B1); PG8_BAR; PG8_SCHED;
            PG8_LDA(At, 1, 1); PG8_STAGE(PG8_SB(1, 0), b3, voffB); PG8_STAGE(PG8_SB(1, 1), b3 + hsB, voffB); PG8_STAGE(PG8_SA(1, 0), a3, voffA);
            PG8_WAIT_V(8); PG8_WAIT_L(0); PG8_BAR; PG8_MMA(1, 0, At, B0); PG8_MMA(1, 1, At, B1); PG8_BAR; PG8_SCHED;
        }
        if (wr == 0) PG8_BAR;
        E(acc, cur, wr, wc, fr, fq);
        if (!has_next) break;
#pragma unroll
        for (int a = 0; a < 2; ++a)
#pragma unroll
            for (int b = 0; b < 2; ++b)
#pragma unroll
                for (int m = 0; m < 4; ++m)
#pragma unroll
                    for (int n = 0; n < 2; ++n) acc[a][b][m][n] = (f32x4){0.f, 0.f, 0.f, 0.f};
        cur = nxt; cA = nA; cB = nB; ++ui;
        if (wr == 1) PG8_BAR;
    }
    PG8_WAIT_V(0);
    PG8_BAR;
#undef PG8_SA
#undef PG8_SB
#undef PG8_STAGE
#undef PG8_LDA
#undef PG8_LDB
#undef PG8_MMA
#undef PG8_WAIT_V
#undef PG8_WAIT_L
#undef PG8_BAR
#undef PG8_SCHED
}
}
using pg8::GUnit;
typedef f32x4 AccT[2][2][4][2];

__host__ __device__ __forceinline__ int rope_cprime(int d) { const int a = d >> 6, b = (d >> 5) & 1, i = d & 31; return 32 * (2 * a + (i >> 4)) + 16 * b + (i & 15); }

struct SchedP2 {
    const bf16_t *hn, *hp, *wint; int G, c;
    __device__ __forceinline__ bool next(int i, GUnit& u) const {
        int L = i * G + c; if (L >= 642) return false;
        if (L < 321) { u.z = 0; if (L == 320) { u.pm = 64; u.pn = 4; } else { u.pm = L / 5; u.pn = L % 5; }
            u.A = (const char*)(hn + (size_t)u.pm * 256 * DM); u.B = (const char*)(wint + (size_t)u.pn * 256 * DM); return true; }
        L -= 321;
        if (L < 65) { u.z = 1; u.pm = 0; u.pn = L; u.A = (const char*)(wint + (size_t)1280 * DM); u.B = (const char*)(hn + (size_t)L * 256 * DM); return true; }
        L -= 65; u.z = 2; u.pm = L & 3; u.pn = L >> 2;
        u.A = (const char*)(wint + (size_t)(1536 + 256 * u.pm) * DM); u.B = (const char*)(hp + (size_t)u.pn * 256 * DM); return true;
    }
};
struct SchedSimple {
    const char *A, *B; int nM, nN, nZ, G, c; size_t aTile, bTile, aZ, bZ;
    __device__ __forceinline__ bool next(int i, GUnit& u) const {
        const int L = i * G + c; if (L >= nM * nN * nZ) return false;
        const int per = nM * nN; u.z = L / per; const int r = L % per; u.pm = r / nN; u.pn = r % nN;
        u.A = A + (size_t)u.z * aZ + (size_t)u.pm * aTile; u.B = B + (size_t)u.z * bZ + (size_t)u.pn * bTile; return true;
    }
};

struct EpiP2 {
    bf16_t *Q, *Kb, *Vt, *Ux; const float *ropeC, *ropeS;
    __device__ __forceinline__ void operator()(const AccT& acc, const GUnit& u, int wr, int wc, int fr, int fq) const {
        if (u.z == 0) {
            const int a = wc >> 1, i0 = (wc & 1) * 16 + 4 * fq;
#pragma unroll
            for (int ai = 0; ai < 2; ++ai)
#pragma unroll
                for (int m = 0; m < 4; ++m) {
                    const int row = 256 * u.pm + 128 * ai + 64 * wr + 16 * m + fr;
                    const bool isctx = row >= SEQ;
                    f32x4 c4 = (f32x4){1.f, 1.f, 1.f, 1.f}, s4 = (f32x4){0.f, 0.f, 0.f, 0.f};
                    if (!isctx) { const int pos = a ? (row & 63) : (row >> 6); c4 = *(const f32x4*)(ropeC + pos * 32 + i0); s4 = *(const f32x4*)(ropeS + pos * 32 + i0); }
#pragma unroll
                    for (int bj = 0; bj < 2; ++bj) {
                        const int hcol = u.pn * 2 + bj;
                        const f32x4 x0 = acc[ai][bj][m][0], x1 = acc[ai][bj][m][1];
                        f32x4 o0 = x0 * c4 - x1 * s4, o1 = x1 * c4 + x0 * s4;
                        if (hcol < 8) { if (!isctx) { o0 = o0 * QSCALE; o1 = o1 * QSCALE; bf16_t* p = Q + (size_t)row * QD + hcol * 128 + 64 * a + i0; *(u32x2*)p = pk4(o0); *(u32x2*)(p + 32) = pk4(o1); } }
                        else { bf16_t* p = Kb + (size_t)row * KVD + (hcol - 8) * 128 + 64 * a + i0; *(u32x2*)p = pk4(o0); *(u32x2*)(p + 32) = pk4(o1); }
                    }
                }
        } else {
            bf16_t* base = (u.z == 1) ? Vt : Ux + (size_t)u.pm * 256 * SEQ;
            const int ld = (u.z == 1) ? NTOK : SEQ;
#pragma unroll
            for (int ai = 0; ai < 2; ++ai)
#pragma unroll
                for (int m = 0; m < 4; ++m) {
                    const int ch = 128 * ai + 64 * wr + 16 * m + fr;
                    bf16_t* rowp = base + (size_t)ch * ld + 256 * u.pn + 32 * wc + 4 * fq;
#pragma unroll
                    for (int bj = 0; bj < 2; ++bj)
#pragma unroll
                        for (int n = 0; n < 2; ++n) *(u32x2*)(rowp + 128 * bj + 16 * n) = pk4(acc[ai][bj][m][n]);
                }
        }
    }
};
struct EpiFFT1 {
    bf16_t* T; const float *twc, *tws;
    __device__ __forceinline__ void operator()(const AccT& acc, const GUnit& u, int wr, int wc, int fr, int fq) const {
#pragma unroll
        for (int m = 0; m < 4; ++m) {
            const int k1 = 64 * wr + 16 * m + fr;
#pragma unroll
            for (int n = 0; n < 2; ++n) {
                const int n2 = 32 * wc + 16 * n + 4 * fq;
                const f32x4 c4 = *(const f32x4*)(twc + k1 * 128 + n2), s4 = *(const f32x4*)(tws + k1 * 128 + n2);
#pragma unroll
                for (int bj = 0; bj < 2; ++bj) {
                    const int j = 2 * u.pn + bj;
                    const f32x4 re = acc[0][bj][m][n], im = acc[1][bj][m][n];
                    const f32x4 ro = re * c4 + im * s4, io = im * c4 - re * s4;
                    bf16_t* p = T + ((size_t)(k1 * 1024 + j) * 2) * 128 + n2;
                    *(u32x2*)p = pk4(ro); *(u32x2*)(p + 128) = pk4(io);
                }
                asm volatile("" ::: "memory");
            }
        }
    }
};
struct EpiFFT2 {
    bf16_t* PQ;
    __device__ __forceinline__ void operator()(const AccT& acc, const GUnit& u, int wr, int wc, int fr, int fq) const {
        const int k1 = u.pn >> 2, g = u.pn & 3;
#pragma unroll
        for (int ai = 0; ai < 2; ++ai)
#pragma unroll
            for (int m = 0; m < 4; ++m) {
                const int k2 = 64 * wr + 16 * m + fr;
                bf16_t* rowp = PQ + (size_t)(k1 + 128 * k2) * DM + g * 512 + ai * 256 + 32 * wc + 4 * fq;
#pragma unroll
                for (int bj = 0; bj < 2; ++bj)
#pragma unroll
                    for (int n = 0; n < 2; ++n) *(u32x2*)(rowp + 128 * bj + 16 * n) = pk4(acc[ai][bj][m][n]);
            }
    }
};
struct EpiFMIX {
    bf16_t* mix;
    __device__ __forceinline__ void operator()(const AccT& acc, const GUnit& u, int wr, int wc, int fr, int fq) const {
#pragma unroll
        for (int ai = 0; ai < 2; ++ai)
#pragma unroll
            for (int m = 0; m < 4; ++m) {
                const int row = 256 * u.pm + 128 * ai + 64 * wr + 16 * m + fr;
                bf16_t* rowp = mix + (size_t)row * DM + 1024 + u.z * 256 + 32 * wc + 4 * fq;
#pragma unroll
                for (int bj = 0; bj < 2; ++bj)
#pragma unroll
                    for (int n = 0; n < 2; ++n) *(u32x2*)(rowp + 128 * bj + 16 * n) = pk4(acc[ai][bj][m][n]);
            }
    }
};
struct EpiOUT {
    const float* x; const float* mod2; float* x1;
    __device__ __forceinline__ void operator()(const AccT& acc, const GUnit& u, int wr, int wc, int fr, int fq) const {
        const int col0 = 256 * u.pn + 32 * wc + 4 * fq;
        f32x4 mv[2][2];
#pragma unroll
        for (int bj = 0; bj < 2; ++bj)
#pragma unroll
            for (int n = 0; n < 2; ++n) mv[bj][n] = *(const f32x4*)(mod2 + col0 + 128 * bj + 16 * n);
#pragma unroll
        for (int ai = 0; ai < 2; ++ai)
#pragma unroll
            for (int m = 0; m < 4; ++m) {
                const int row = 256 * u.pm + 128 * ai + 64 * wr + 16 * m + fr;
                const size_t off = (size_t)row * DM + col0;
#pragma unroll
                for (int bj = 0; bj < 2; ++bj)
#pragma unroll
                    for (int n = 0; n < 2; ++n) { const f32x4 xv = *(const f32x4*)(x + off + 128 * bj + 16 * n); *(f32x4*)(x1 + off + 128 * bj + 16 * n) = xv + mv[bj][n] * acc[ai][bj][m][n]; }
                asm volatile("" ::: "memory");
            }
    }
};
struct EpiUP {
    bf16_t* hmid;
    __device__ __forceinline__ void operator()(const AccT& acc, const GUnit& u, int wr, int wc, int fr, int fq) const {
#pragma unroll
        for (int ai = 0; ai < 2; ++ai)
#pragma unroll
            for (int m = 0; m < 4; ++m) {
                const int row = u.z * CAP + 256 * u.pm + 128 * ai + 64 * wr + 16 * m + fr;
                bf16_t* rowp = hmid + (size_t)row * FF + 128 * u.pn + 32 * wc + 4 * fq;
#pragma unroll
                for (int n = 0; n < 2; ++n) { const f32x4 gv = acc[ai][0][m][n], uv = acc[ai][1][m][n]; f32x4 h;
#pragma unroll
                    for (int e = 0; e < 4; ++e) h[e] = siluf(gv[e]) * uv[e];
                    *(u32x2*)(rowp + 16 * n) = pk4(h); }
            }
    }
};
struct EpiDOWN {
    bf16_t* slab; const float* gate;
    __device__ __forceinline__ void operator()(const AccT& acc, const GUnit& u, int wr, int wc, int fr, int fq) const {
#pragma unroll
        for (int ai = 0; ai < 2; ++ai)
#pragma unroll
            for (int m = 0; m < 4; ++m) {
                const int row = u.z * CAP + 256 * u.pm + 128 * ai + 64 * wr + 16 * m + fr;
                const float gt = gate[row];
                bf16_t* rowp = slab + (size_t)row * DM + 256 * u.pn + 32 * wc + 4 * fq;
#pragma unroll
                for (int bj = 0; bj < 2; ++bj)
#pragma unroll
                    for (int n = 0; n < 2; ++n) *(u32x2*)(rowp + 128 * bj + 16 * n) = pk4(acc[ai][bj][m][n] * gt);
            }
    }
};

struct Frame { LAS unsigned char* lds; int tid, lane, wave, G, vcu, gw, NGW; };

__device__ __forceinline__ void p0_mod_item(const Params& P, float* modp, int item, int lane) {
    const int kc = item / 48, nc = item % 48;
    const float cx0 = P.c[128 * kc + lane], cx1 = P.c[128 * kc + 64 + lane], cc0 = P.c_ctx[128 * kc + lane], cc1 = P.c_ctx[128 * kc + 64 + lane];
    const float sx0 = siluf(cx0), sx1 = siluf(cx1), sc0 = siluf(cc0), sc1 = siluf(cc1);
    f32x4 ax = (f32x4){0.f, 0.f, 0.f, 0.f}, ac = ax;
    const float* wp = P.w_mod + (size_t)(128 * kc) * NMOD + 256 * nc + 4 * lane;
#pragma unroll 8
    for (int k = 0; k < 64; ++k) { const f32x4 w = *(const f32x4*)(wp + (size_t)k * NMOD); const float sx = __shfl(sx0, k), sc = __shfl(sc0, k); ax += w * sx; ac += w * sc; }
#pragma unroll 8
    for (int k = 0; k < 64; ++k) { const f32x4 w = *(const f32x4*)(wp + (size_t)(64 + k) * NMOD); const float sx = __shfl(sx1, k), sc = __shfl(sc1, k); ax += w * sx; ac += w * sc; }
    *(f32x4*)(modp + (size_t)(kc * 2 + 0) * NMOD + 256 * nc + 4 * lane) = ax;
    *(f32x4*)(modp + (size_t)(kc * 2 + 1) * NMOD + 256 * nc + 4 * lane) = ac;
}
template <class RowMap>
__device__ __forceinline__ void p0_transpose_item(const float* W, int K, int N, bf16_t* WT, const RowMap& rm, LAS float* scr, int item, int lane) {
    const int nblk = N / 32, kb = item / nblk, nb = item % nblk, k0 = 64 * kb, n0 = 32 * nb;
#pragma unroll 8
    for (int i = 0; i < 32; ++i) { const int kk = 2 * i + (lane >> 5); scr[kk * 33 + (lane & 31)] = W[(size_t)(k0 + kk) * N + n0 + (lane & 31)]; }
    LDS_WAIT();
    const int c = lane & 7;
#pragma unroll
    for (int j = 0; j < 4; ++j) { const int n = (lane >> 3) + 8 * j; const LAS float* s = scr + (8 * c) * 33 + n;
        u32x4 o; o.x = pk2(s[0 * 33], s[1 * 33]); o.y = pk2(s[2 * 33], s[3 * 33]); o.z = pk2(s[4 * 33], s[5 * 33]); o.w = pk2(s[6 * 33], s[7 * 33]);
        *(u32x4*)(WT + (size_t)rm(n0 + n) * K + k0 + 8 * c) = o; }
    LDS_WAIT();
}
struct RmIdent { int off; __device__ __forceinline__ int operator()(int n) const { return off + n; } };
struct RmWin { __device__ __forceinline__ int operator()(int n) const { if (n >= 1280) return n; return (n & ~127) + rope_cprime(n & 127); } };
struct RmGU { int up; __device__ __forceinline__ int operator()(int f) const { return 256 * (f >> 7) + 128 * up + (f & 127); } };

__device__ __forceinline__ void p0_prep(const Frame& F, const Params& P) {
    unsigned char* ws = P.ws;
    LAS float* scr = (LAS float*)(F.lds + F.wave * 16384);
    constexpr int I_MOD = 768;
    constexpr int I_WIN = (DM / 64) * (DIN / 32);
    constexpr int I_WOUT = (DM / 64) * (DM / 32);
    constexpr int I_GU = (DM / 64) * (FF / 32);
    constexpr int I_DN = (FF / 64) * (DM / 32);
    constexpr int I_TAB = 32 + 64 + 16 + 8;
    constexpr int I_MGT = 2048;
    constexpr int NITEMS = I_MOD + I_WIN + I_WOUT + NE * (2 * I_GU + I_DN) + I_TAB + I_MGT;
    bf16_t* wint = (bf16_t*)(ws + WS_WINT); bf16_t* wot = (bf16_t*)(ws + WS_WOT); bf16_t* wgu = (bf16_t*)(ws + WS_WGU); bf16_t* wd = (bf16_t*)(ws + WS_WD);
    for (int it = F.gw; it < NITEMS; it += F.NGW) {
        int r = it;
        if (r < I_MOD) { p0_mod_item(P, (float*)(ws + WS_MODP), r, F.lane); continue; } r -= I_MOD;
        if (r < I_WIN) { p0_transpose_item(P.w_in, DM, DIN, wint, RmWin{}, scr, r, F.lane); continue; } r -= I_WIN;
        if (r < I_WOUT) { p0_transpose_item(P.w_out, DM, DM, wot, RmIdent{0}, scr, r, F.lane); continue; } r -= I_WOUT;
        if (r < NE * 2 * I_GU) { const int e = r / (2 * I_GU), q = r % (2 * I_GU), up = q / I_GU, ii = q % I_GU;
            p0_transpose_item((up ? P.w_up : P.w_gate) + (size_t)e * DM * FF, DM, FF, wgu + (size_t)e * 2048 * DM, RmGU{up}, scr, ii, F.lane); continue; } r -= NE * 2 * I_GU;
        if (r < NE * I_DN) { const int e = r / I_DN, ii = r % I_DN; p0_transpose_item(P.w_down + (size_t)e * FF * DM, FF, DM, wd + (size_t)e * DM * FF, RmIdent{0}, scr, ii, F.lane); continue; } r -= NE * I_DN;
        if (r < I_TAB) {
            for (int q = 0; q < 16; ++q) {
                const int el = r * 1024 + q * 64 + F.lane;
                if (el < 32768) {
                    const int row = el >> 7, n1 = el & 127, k1 = row & 127, reim = row >> 7; const int ph = (k1 * n1) & 127;
                    const float v = reim ? -sinpif((float)ph * (1.0f / 64.0f)) : cospif((float)ph * (1.0f / 64.0f));
                    ((bf16_t*)(ws + WS_F1))[el] = f2bf(v);
                } else if (el < 32768 + 65536) {
                    const int e2 = el - 32768, row = e2 >> 8, col = e2 & 255, pq = row >> 7, k2 = row & 127, reim = col >> 7, n2 = col & 127; const int ph = (k2 * n2) & 127;
                    const float cs = cospif((float)ph * (1.0f / 64.0f)), sn = sinpif((float)ph * (1.0f / 64.0f));
                    const float v = (pq == 0) ? (reim == 0 ? cs : sn) : (reim == 0 ? sn : -cs);
                    ((bf16_t*)(ws + WS_G2))[e2] = f2bf(v);
                } else if (el < 32768 + 65536 + 16384) {
                    const int e2 = el - 32768 - 65536, k1 = e2 >> 7, n2 = e2 & 127; const float ph = (float)(k1 * n2) * (1.0f / 8192.0f);
                    ((float*)(ws + WS_TWC))[e2] = cospif(ph); ((float*)(ws + WS_TWS))[e2] = sinpif(ph);
                } else {
                    const int e2 = el - 32768 - 65536 - 16384, pos = e2 >> 5, i = e2 & 31;
                    const double fr = pow(10000.0, -(double)i / 32.0), ang = (double)pos * fr;
                    ((float*)(ws + WS_ROPEC))[e2] = (float)cos(ang); ((float*)(ws + WS_ROPES))[e2] = (float)sin(ang);
                }
            }
            continue;
        } r -= I_TAB;
        {
            LAS float* ctab = scr;
            for (int q = 0; q < 4; ++q) ctab[q * 64 + F.lane] = cospif((float)(q * 64 + F.lane) * (1.0f / 128.0f));
            LDS_WAIT();
            const int g = r >> 9, d = (r >> 1) & 255, pq = r & 1;
            const float* wf = P.w_f + (size_t)g * 256 * 256 + d;
            float a0 = 0.f, a1 = 0.f, a2 = 0.f, a3 = 0.f;
            for (int m = 0; m < 256; ++m) {
                const float w = wf[(size_t)m * 256];
                const int sh = pq ? 64 : 0;
                a0 += w * ctab[(m * (F.lane) + sh) & 255];
                a1 += w * ctab[(m * (F.lane + 64) + sh) & 255];
                a2 += w * ctab[(m * (F.lane + 128) + sh) & 255];
                a3 += w * ctab[(m * (F.lane + 192) + sh) & 255];
            }
            bf16_t* o = (bf16_t*)(ws + WS_MGT) + ((size_t)(g * 256 + d)) * 512 + pq * 256 + F.lane;
            o[0] = f2bf(a0 * (1.0f / 2048.0f)); o[64] = f2bf(a1 * (1.0f / 2048.0f)); o[128] = f2bf(a2 * (1.0f / 2048.0f)); o[192] = f2bf(a3 * (1.0f / 2048.0f));
            LDS_WAIT();
        }
    }
}

__device__ __forceinline__ float mod_final(const float* modp, const float* b_mod, int which, int col) {
    float s = b_mod[col];
    const float* p = modp + (size_t)which * NMOD + col;
#pragma unroll 4
    for (int kc = 0; kc < 16; ++kc) s += p[(size_t)kc * 2 * NMOD];
    return s;
}
__device__ __forceinline__ void p1_norm(const Frame& F, const Params& P) {
    unsigned char* ws = P.ws;
    const float* modp = (const float*)(ws + WS_MODP);
    LAS float* Ax = (LAS float*)F.lds; LAS float* Bx = Ax + DM; LAS float* Ac = Bx + DM; LAS float* Bc = Ac + DM;
#pragma unroll 1
    for (int k = F.tid; k < DM; k += NTHREADS) {
        const float g = P.norm_mix[k];
        Ax[k] = g * (1.0f + mod_final(modp, P.b_mod, 0, DM + k)); Bx[k] = mod_final(modp, P.b_mod, 0, k);
        Ac[k] = g * (1.0f + mod_final(modp, P.b_mod, 1, DM + k)); Bc[k] = mod_final(modp, P.b_mod, 1, k);
    }
    float* modf = (float*)(ws + WS_MODF);
    for (int col = blockIdx.x * NTHREADS + F.tid; col < NMOD; col += F.G * NTHREADS) modf[col] = mod_final(modp, P.b_mod, 0, col);
    __syncthreads();
    bf16_t* hn = (bf16_t*)(ws + RA_HN); bf16_t* hp = (bf16_t*)(ws + RA_HP);
    for (int r = F.gw; r < NTOK; r += F.NGW) {
        const bool isx = r < SEQ;
        const float* src = isx ? P.x + (size_t)r * DM : P.ctx + (size_t)(r - SEQ) * DM;
        const LAS float* A = isx ? Ax : Ac; const LAS float* B = isx ? Bx : Bc;
        f32x4 v[8]; float ss = 0.f;
#pragma unroll
        for (int j = 0; j < 8; ++j) { v[j] = *(const f32x4*)(src + 256 * j + 4 * F.lane); ss += (v[j][0] * v[j][0] + v[j][1] * v[j][1]) + (v[j][2] * v[j][2] + v[j][3] * v[j][3]); }
        const float rs = rsqrtf(wave_sum(ss) * (1.0f / DM) + RMS_EPS);
        bf16_t* d0 = hn + (size_t)r * DM; bf16_t* d1 = isx ? hp + (size_t)((r & 127) * 128 + (r >> 7)) * DM : nullptr;
#pragma unroll
        for (int j = 0; j < 8; ++j) { const int k = 256 * j + 4 * F.lane; const f32x4 a = *(const LAS f32x4*)(A + k), b = *(const LAS f32x4*)(B + k);
            const u32x2 o = pk4(v[j] * rs * a + b); *(u32x2*)(d0 + k) = o; if (isx) *(u32x2*)(d1 + k) = o; }
    }
}

constexpr int AT_KB = 16384, AT_VB = 128 * 136, AT_BUF = AT_KB + AT_VB;
__device__ __forceinline__ void attn_item(const Frame& F, int item, const bf16_t* Q, const bf16_t* Kb, const bf16_t* Vt, bf16_t* mix, const float* sink) {
    const int qb = item >> 1, kvh = item & 1, q0 = qb * 64;
    const int tid = F.tid, lane = F.lane, wid = F.wave, head = kvh * 4 + (wid >> 1), sb = wid & 1, r32 = lane & 31, hi = lane >> 5;
    const int qrow = q0 + 32 * sb + r32;
    bf16x8 qf[8];
#pragma unroll
    for (int s = 0; s < 8; ++s) qf[s] = *(const bf16x8*)(Q + (size_t)qrow * QD + head * 128 + 16 * s + 8 * hi);
    float mrun = sink[head] * LOG2E, lrun = hi ? 0.f : 1.f;
    f32x16 o[4];
#pragma unroll
    for (int d = 0; d < 4; ++d)
#pragma unroll
        for (int r = 0; r < 16; ++r) o[d][r] = 0.f;
    int lt_lo = 0, lt_hi = 4;
    if (q0 - 128 < 0) lt_lo = (128 - q0) / 64;
    if (q0 - 128 + 64 * 4 >= SEQ) lt_hi = (SEQ - 1 - (q0 - 128)) / 64;
    const int nloc = lt_hi - lt_lo + 1, ntile = nloc + 4;
    u32x4 kreg[2], vreg[2];
    auto tile_start = [&](int t) -> int { return t < nloc ? (q0 - 128 + 64 * (lt_lo + t)) : (SEQ + 64 * (t - nloc)); };
    auto gload = [&](int t) {
        const int ks = tile_start(t);
#pragma unroll
        for (int i = 0; i < 2; ++i) { const int c = tid + 512 * i;
            kreg[i] = *(const u32x4*)(Kb + (size_t)(ks + (c >> 4)) * KVD + kvh * 128 + (c & 15) * 8);
            vreg[i] = *(const u32x4*)(Vt + (size_t)(kvh * 128 + (c >> 3)) * NTOK + ks + (c & 7) * 8); }
    };
    auto lwrite = [&](int buf) {
        LAS unsigned char* kb = F.lds + buf * AT_BUF; LAS unsigned char* vb = kb + AT_KB;
#pragma unroll
        for (int i = 0; i < 2; ++i) { const int c = tid + 512 * i; const int row = c >> 4, ch = c & 15;
            *(LAS u32x4*)(kb + row * 256 + ((ch ^ (row & 15)) << 4)) = kreg[i];
            const int dr = c >> 3, vc = c & 7; LAS unsigned char* vp = vb + dr * 136 + vc * 16;
            *(LAS u32x2*)vp = (u32x2){vreg[i].x, vreg[i].y}; *(LAS u32x2*)(vp + 8) = (u32x2){vreg[i].z, vreg[i].w}; }
    };
    gload(0); lwrite(0); __syncthreads();
    for (int t = 0; t < ntile; ++t) {
        if (t + 1 < ntile) gload(t + 1);
        const LAS unsigned char* kb = F.lds + (t & 1) * AT_BUF; const LAS unsigned char* vb = kb + AT_KB;
        f32x16 p0, p1;
#pragma unroll
        for (int r = 0; r < 16; ++r) { p0[r] = 0.f; p1[r] = 0.f; }
#pragma unroll
        for (int s = 0; s < 8; ++s) {
            const int ch = 2 * s + hi;
            const bf16x8 a0 = *(const LAS bf16x8*)(kb + r32 * 256 + ((ch ^ (r32 & 15)) << 4));
            const bf16x8 a1 = *(const LAS bf16x8*)(kb + (32 + r32) * 256 + ((ch ^ (r32 & 15)) << 4));
            p0 = __builtin_amdgcn_mfma_f32_32x32x16_bf16(a0, qf[s], p0, 0, 0, 0);
            p1 = __builtin_amdgcn_mfma_f32_32x32x16_bf16(a1, qf[s], p1, 0, 0, 0);
        }
        if (t < nloc) {
            const int lt = lt_lo + t, ks = q0 - 128 + 64 * lt;
            if (lt == 0 || lt == 4) {
#pragma unroll
                for (int r = 0; r < 16; ++r) { const int key = ks + (r & 3) + 8 * (r >> 2) + 4 * hi; int d0 = qrow - key; d0 = d0 < 0 ? -d0 : d0; int d1 = qrow - (key + 32); d1 = d1 < 0 ? -d1 : d1;
                    if (d0 > 128) p0[r] = -1e30f; if (d1 > 128) p1[r] = -1e30f; }
            }
        }
        float mx = p0[0];
#pragma unroll
        for (int r = 1; r < 16; ++r) mx = fmaxf(mx, p0[r]);
#pragma unroll
        for (int r = 0; r < 16; ++r) mx = fmaxf(mx, p1[r]);
        mx = fmaxf(mx, __shfl_xor(mx, 32));
        const float mnew = fmaxf(mrun, mx), alpha = exp2f(mrun - mnew);
        mrun = mnew;
        float ls = 0.f;
#pragma unroll
        for (int r = 0; r < 16; ++r) { p0[r] = exp2f(p0[r] - mnew); p1[r] = exp2f(p1[r] - mnew); ls += p0[r] + p1[r]; }
        lrun = lrun * alpha + ls;
#pragma unroll
        for (int d = 0; d < 4; ++d)
#pragma unroll
            for (int r = 0; r < 16; ++r) o[d][r] *= alpha;
        bf16x8 pk[4];
#pragma unroll
        for (int s = 0; s < 2; ++s) {
            u32x4 w0, w1;
            w0.x = pk2(p0[8 * s + 0], p0[8 * s + 1]); w0.y = pk2(p0[8 * s + 2], p0[8 * s + 3]); w0.z = pk2(p0[8 * s + 4], p0[8 * s + 5]); w0.w = pk2(p0[8 * s + 6], p0[8 * s + 7]);
            w1.x = pk2(p1[8 * s + 0], p1[8 * s + 1]); w1.y = pk2(p1[8 * s + 2], p1[8 * s + 3]); w1.z = pk2(p1[8 * s + 4], p1[8 * s + 5]); w1.w = pk2(p1[8 * s + 6], p1[8 * s + 7]);
            pk[s] = __builtin_bit_cast(bf16x8, w0); pk[2 + s] = __builtin_bit_cast(bf16x8, w1);
        }
#pragma unroll
        for (int d = 0; d < 4; ++d) {
            const LAS unsigned char* vrow = vb + (32 * d + r32) * 136;
#pragma unroll
            for (int ks = 0; ks < 4; ++ks) {
                const u32x2 lo = *(const LAS u32x2*)(vrow + (16 * ks + 4 * hi) * 2), hi2 = *(const LAS u32x2*)(vrow + (16 * ks + 8 + 4 * hi) * 2);
                const u32x4 av = (u32x4){lo.x, lo.y, hi2.x, hi2.y};
                o[d] = __builtin_amdgcn_mfma_f32_32x32x16_bf16(__builtin_bit_cast(bf16x8, av), pk[ks], o[d], 0, 0, 0);
            }
        }
        if (t + 1 < ntile) lwrite((t + 1) & 1);
        __syncthreads();
    }
    const float ltot = lrun + __shfl_xor(lrun, 32), inv = 1.0f / ltot;
    bf16_t* orow = mix + (size_t)qrow * DM + head * 128;
#pragma unroll
    for (int d = 0; d < 4; ++d)
#pragma unroll
        for (int g = 0; g < 4; ++g) {
            const f32x4 v = (f32x4){o[d][4 * g] * inv, o[d][4 * g + 1] * inv, o[d][4 * g + 2] * inv, o[d][4 * g + 3] * inv};
            *(u32x2*)(orow + 32 * d + 8 * g + 4 * hi) = pk4(v);
        }
}

__device__ __forceinline__ void p7_router(const Frame& F, const Params& P, const float* x1) {
    unsigned char* ws = P.ws;
    const float* modf = (const float*)(ws + WS_MODF);
    LAS float* wr = (LAS float*)F.lds;
    for (int idx = F.tid; idx < DM * NE; idx += NTHREADS) { const int k = idx >> 4, e = idx & 15; wr[e * DM + k] = P.w_router[idx]; }
    __syncthreads();
    f32x4 Af[8], Bf[8];
#pragma unroll
    for (int j = 0; j < 8; ++j) { const int k = 256 * j + 4 * F.lane; const f32x4 g = *(const f32x4*)(P.norm_ffn + k), sc = *(const f32x4*)(modf + 4 * DM + k); Af[j] = g * (1.0f + sc); Bf[j] = *(const f32x4*)(modf + 3 * DM + k); }
    bf16_t* gx = (bf16_t*)(ws + RA_GX); float* aff = (float*)(ws + WS_AFF);
    for (int r = F.gw; r < SEQ; r += F.NGW) {
        const float* src = x1 + (size_t)r * DM;
        f32x4 v[8]; float ss = 0.f;
#pragma unroll
        for (int j = 0; j < 8; ++j) { v[j] = *(const f32x4*)(src + 256 * j + 4 * F.lane); ss += (v[j][0] * v[j][0] + v[j][1] * v[j][1]) + (v[j][2] * v[j][2] + v[j][3] * v[j][3]); }
        const float rs = rsqrtf(wave_sum(ss) * (1.0f / DM) + RMS_EPS);
        bf16_t* d0 = gx + (size_t)r * DM;
#pragma unroll
        for (int j = 0; j < 8; ++j) { v[j] = v[j] * rs * Af[j] + Bf[j]; *(u32x2*)(d0 + 256 * j + 4 * F.lane) = pk4(v[j]); }
        float mylg = 0.f;
#pragma unroll 1
        for (int e = 0; e < 16; ++e) { float a = 0.f;
#pragma unroll
            for (int j = 0; j < 8; ++j) { const f32x4 w = *(const LAS f32x4*)(wr + e * DM + 256 * j + 4 * F.lane); a += (v[j][0] * w[0] + v[j][1] * w[1]) + (v[j][2] * w[2] + v[j][3] * w[3]); }
            a = wave_sum(a); mylg = (F.lane == e) ? a : mylg; }
        float mx = mylg;
#pragma unroll
        for (int o = 1; o < 16; o <<= 1) mx = fmaxf(mx, __shfl_xor(mx, o));
        const float ex = __expf(mylg - mx);
        float sum = ex;
#pragma unroll
        for (int o = 1; o < 16; o <<= 1) sum += __shfl_xor(sum, o);
        const float mine = ex / sum;
        if (F.lane < 16) aff[(size_t)F.lane * SEQ + r] = mine;
    }
    __syncthreads();
}

__device__ __forceinline__ int block_excl_scan(int v, LAS int* sc, int tid, int* tot) {
    const int lane = tid & 63, w = tid >> 6;
    int inc = v;
#pragma unroll
    for (int o = 1; o < 64; o <<= 1) { const int t = __shfl_up(inc, o); if (lane >= o) inc += t; }
    __syncthreads();
    if (lane == 63) sc[w] = inc;
    __syncthreads();
    int base = 0, total = 0;
#pragma unroll
    for (int i = 0; i < 8; ++i) { const int s = sc[i]; if (i < w) base += s; total += s; }
    *tot = total;
    return base + inc - v;
}
__device__ __forceinline__ void p8_select(const Frame& F, const Params& P) {
    if ((int)blockIdx.x >= NE) return;
    unsigned char* ws = P.ws;
    const int e = blockIdx.x, tid = F.tid;
    const float* aff = (const float*)(ws + WS_AFF) + (size_t)e * SEQ;
    int* idx = (int*)(ws + WS_IDX) + e * CAP; float* gate = (float*)(ws + WS_GATE) + e * CAP; int* slot = (int*)(ws + WS_SLOT) + (size_t)e * SEQ;
    LAS int* hist = (LAS int*)F.lds;
    LAS int* sc = hist + 2048;
    LAS int* res = sc + 16;
    unsigned v[32];
#pragma unroll
    for (int j = 0; j < 8; ++j) { const u32x4 t = *(const u32x4*)(aff + 32 * tid + 4 * j); v[4 * j] = t.x; v[4 * j + 1] = t.y; v[4 * j + 2] = t.z; v[4 * j + 3] = t.w; }
    unsigned prefix = 0; int remaining = CAP;
#pragma unroll
    for (int pass = 0; pass < 3; ++pass) {
        const int shift = pass == 0 ? 21 : (pass == 1 ? 10 : 0), nb = pass == 2 ? 1024 : 2048;
        const unsigned himask = pass == 0 ? 0u : (pass == 1 ? 0xFFE00000u : 0xFFFFFC00u);
        for (int b = tid; b < 2048; b += NTHREADS) hist[b] = 0;
        __syncthreads();
#pragma unroll
        for (int j = 0; j < 32; ++j) if ((v[j] & himask) == prefix) __hip_atomic_fetch_add(hist + ((v[j] >> shift) & (nb - 1)), 1, __ATOMIC_RELAXED, __HIP_MEMORY_SCOPE_WORKGROUP);
        __syncthreads();
        const int h0 = hist[4 * tid], h1 = hist[4 * tid + 1], h2 = hist[4 * tid + 2], h3 = hist[4 * tid + 3];
        int tot; const int ex = block_excl_scan(h0 + h1 + h2 + h3, sc, tid, &tot);
        int above = tot - ex - (h0 + h1 + h2 + h3);
        const int hh[4] = {h0, h1, h2, h3};
#pragma unroll
        for (int q = 3; q >= 0; --q) { if (above < remaining && above + hh[q] >= remaining) { res[0] = 4 * tid + q; res[1] = remaining - above; } above += hh[q]; }
        __syncthreads();
        prefix |= ((unsigned)res[0]) << shift; remaining = res[1];
        __syncthreads();
    }
    const unsigned T = prefix;
    int ceq = 0;
#pragma unroll
    for (int j = 0; j < 32; ++j) ceq += (v[j] == T) ? 1 : 0;
    int tot; int eqbase = block_excl_scan(ceq, sc, tid, &tot);
    unsigned selmask = 0; int csel = 0;
#pragma unroll
    for (int j = 0; j < 32; ++j) { bool s = v[j] > T; if (v[j] == T) { s = eqbase < remaining; ++eqbase; } if (s) { selmask |= 1u << j; ++csel; } }
    int sbase = block_excl_scan(csel, sc, tid, &tot);
#pragma unroll
    for (int j = 0; j < 32; ++j) { const int t = 32 * tid + j; int sl = -1; if ((selmask >> j) & 1u) { sl = sbase++; if (sl < CAP) { idx[sl] = t; gate[sl] = __builtin_bit_cast(float, v[j]); } } slot[t] = sl; }
}

__device__ __forceinline__ void p8b_gather(const Frame& F, const Params& P) {
    unsigned char* ws = P.ws;
    const bf16_t* gx = (const bf16_t*)(ws + RA_GX); bf16_t* xs = (bf16_t*)(ws + RB_XS); const int* idx = (const int*)(ws + WS_IDX);
    for (int r = F.gw; r < NE * CAP; r += F.NGW) {
        const int t = idx[r];
        const u32x4* s = (const u32x4*)(gx + (size_t)t * DM); u32x4* d = (u32x4*)(xs + (size_t)r * DM);
#pragma unroll
        for (int j = 0; j < 4; ++j) d[64 * j + F.lane] = s[64 * j + F.lane];
    }
}

__device__ __forceinline__ void p11_final(const Frame& F, const Params& P, float* x1out) {
    unsigned char* ws = P.ws;
    const float* modf = (const float*)(ws + WS_MODF); const bf16_t* slab = (const bf16_t*)(ws + RB_SLAB); const int* slot = (const int*)(ws + WS_SLOT);
    f32x4 m5[8], nf[8];
#pragma unroll
    for (int j = 0; j < 8; ++j) { const int k = 256 * j + 4 * F.lane; m5[j] = *(const f32x4*)(modf + 5 * DM + k); nf[j] = *(const f32x4*)(P.norm_final + k); }
    for (int r = F.gw; r < SEQ; r += F.NGW) {
        float* row = x1out + (size_t)r * DM;
        f32x4 v[8], a[8];
#pragma unroll
        for (int j = 0; j < 8; ++j) { v[j] = *(const f32x4*)(row + 256 * j + 4 * F.lane); a[j] = (f32x4){0.f, 0.f, 0.f, 0.f}; }
        for (int e = 0; e < NE; ++e) {
            const int sl = __builtin_amdgcn_readfirstlane(slot[(size_t)e * SEQ + r]);
            if (sl >= 0) { const bf16_t* y = slab + (size_t)(e * CAP + sl) * DM;
#pragma unroll
                for (int j = 0; j < 8; ++j) { const u32x2 w = *(const u32x2*)(y + 256 * j + 4 * F.lane);
                    a[j][0] += __builtin_bit_cast(float, w.x << 16); a[j][1] += __builtin_bit_cast(float, w.x & 0xffff0000u); a[j][2] += __builtin_bit_cast(float, w.y << 16); a[j][3] += __builtin_bit_cast(float, w.y & 0xffff0000u); } }
        }
        float ss = 0.f;
#pragma unroll
        for (int j = 0; j < 8; ++j) { v[j] = v[j] + m5[j] * a[j]; ss += (v[j][0] * v[j][0] + v[j][1] * v[j][1]) + (v[j][2] * v[j][2] + v[j][3] * v[j][3]); }
        const float rs = rsqrtf(wave_sum(ss) * (1.0f / DM) + RMS_EPS);
#pragma unroll
        for (int j = 0; j < 8; ++j) *(f32x4*)(row + 256 * j + 4 * F.lane) = v[j] * rs * nf[j];
    }
}

#if SELF_CHECK
#include "selfcheck.inc"
#endif
__global__ void __launch_bounds__(NTHREADS, 2) mega_fwd(Params P) {
    extern __shared__ __attribute__((aligned(16))) unsigned char lds_raw[];
    cg::grid_group grid = cg::this_grid();
    Frame F;
    F.lds = (LAS unsigned char*)lds_raw;
    F.tid = threadIdx.x; F.lane = F.tid & 63; F.wave = __builtin_amdgcn_readfirstlane(F.tid >> 6);
    F.G = gridDim.x; { const int bx = blockIdx.x; F.vcu = (F.G % 8 == 0) ? (bx % 8) * (F.G / 8) + bx / 8 : bx; }
    F.gw = F.vcu * NWAVES + F.wave; F.NGW = F.G * NWAVES;
    unsigned char* ws = P.ws;
    const int bid = blockIdx.x, G = F.G;
    bf16_t* hn = (bf16_t*)(ws + RA_HN); bf16_t* hp = (bf16_t*)(ws + RA_HP); bf16_t* wint = (bf16_t*)(ws + WS_WINT);
    bf16_t* Q = (bf16_t*)(ws + RB_Q); bf16_t* Kb = (bf16_t*)(ws + RB_K); bf16_t* Vt = (bf16_t*)(ws + RB_VT); bf16_t* Ux = (bf16_t*)(ws + RB_UX);
    bf16_t* Tb = (bf16_t*)(ws + RA_T); bf16_t* PQ = (bf16_t*)(ws + RA_PQ); bf16_t* mix = (bf16_t*)(ws + WS_RC);
    bf16_t* xs = (bf16_t*)(ws + RB_XS); bf16_t* hmid = (bf16_t*)(ws + RA_HMID); bf16_t* slab = (bf16_t*)(ws + RB_SLAB);
    float* x1 = P.out;
#define REFRESH() do { int t_ = threadIdx.x; asm volatile("" : "+v"(t_)); F.tid = t_; F.lane = t_ & 63; F.wave = __builtin_amdgcn_readfirstlane(t_ >> 6); F.gw = F.vcu * NWAVES + F.wave; } while (0)
#if SELF_CHECK
#define CHECK(n) do { grid.sync(); selfcheck_##n(F, P); } while (0)
#else
#define CHECK(n) do { } while (0)
#endif

    p0_prep(F, P);
    grid.sync(); REFRESH();
    p1_norm(F, P);
    grid.sync(); REFRESH();
    CHECK(1);
    { SchedP2 S{hn, hp, wint, G, bid}; EpiP2 E{Q, Kb, Vt, Ux, (const float*)(ws + WS_ROPEC), (const float*)(ws + WS_ROPES)};
      pg8::gemm_phase(F.lds, DM, DM, DM, S, E); }
    grid.sync(); REFRESH();
    CHECK(2);
    for (int it = F.vcu; it < 512; it += G) attn_item(F, it, Q, Kb, Vt, mix, P.sink);
    { SchedSimple S{(const char*)(ws + WS_F1), (const char*)Ux, 1, 512, 1, G, bid, 0, (size_t)256 * 128 * 2, 0, 0}; EpiFFT1 E{Tb, (const float*)(ws + WS_TWC), (const float*)(ws + WS_TWS)};
      int kk; asm volatile("s_mov_b32 %0, 128" : "=s"(kk));
      pg8::gemm_phase(F.lds, kk, 128, 128, S, E); }
    grid.sync(); REFRESH();
    CHECK(3);
    { SchedSimple S{(const char*)(ws + WS_G2), (const char*)Tb, 1, 512, 1, G, bid, 0, (size_t)256 * 256 * 2, 0, 0}; EpiFFT2 E{PQ};
      pg8::gemm_phase(F.lds, 256, 256, 256, S, E); }
    grid.sync(); REFRESH();
    CHECK(4);
    { SchedSimple S{(const char*)PQ, (const char*)(ws + WS_MGT), 64, 1, 4, G, bid, (size_t)256 * DM * 2, 0, (size_t)512 * 2, (size_t)256 * 512 * 2}; EpiFMIX E{mix};
      pg8::gemm_phase(F.lds, 512, DM, 512, S, E); }
    grid.sync(); REFRESH();
    CHECK(5);
    { SchedSimple S{(const char*)mix, (const char*)(ws + WS_WOT), 64, 8, 1, G, bid, (size_t)256 * DM * 2, (size_t)256 * DM * 2, 0, 0}; EpiOUT E{P.x, (const float*)(ws + WS_MODF) + 2 * DM, x1};
      pg8::gemm_phase(F.lds, DM, DM, DM, S, E); }
    grid.sync(); REFRESH();
    CHECK(6);
    p7_router(F, P, x1);
    grid.sync(); REFRESH();
    CHECK(7);
    p8_select(F, P);
    grid.sync(); REFRESH();
    p8b_gather(F, P);
    grid.sync(); REFRESH();
    CHECK(8);
    { SchedSimple S{(const char*)xs, (const char*)(ws + WS_WGU), 8, 8, 16, G, bid, (size_t)256 * DM * 2, (size_t)256 * DM * 2, (size_t)CAP * DM * 2, (size_t)2048 * DM * 2}; EpiUP E{hmid};
      pg8::gemm_phase(F.lds, DM, DM, DM, S, E); }
    grid.sync(); REFRESH();
    CHECK(9);
    { SchedSimple S{(const char*)hmid, (const char*)(ws + WS_WD), 8, 8, 16, G, bid, (size_t)256 * FF * 2, (size_t)256 * FF * 2, (size_t)CAP * FF * 2, (size_t)DM * FF * 2}; EpiDOWN E{slab, (const float*)(ws + WS_GATE)};
      pg8::gemm_phase(F.lds, FF, FF, FF, S, E); }
    grid.sync(); REFRESH();
    CHECK(10);
    p11_final(F, P, x1);
#if SELF_CHECK
    grid.sync(); REFRESH();
    selfcheck_report(F, P);
#endif
}

extern "C" void kernel_launch(void* const* d_in, const int* in_sizes, int n_in, void* d_out, int out_size, void* d_ws, size_t ws_size, hipStream_t stream) {
    static int grid = 0;
    if (grid == 0) {
        if (n_in != 17 || out_size != SEQ * DM || ws_size < WS_END) { fprintf(stderr, "kernel_launch: unexpected shapes (n_in %d out %d ws %zu)\n", n_in, out_size, ws_size); grid = -1; return; }
        int dev = 0, cus = 0, per_cu = 0;
        hipGetDevice(&dev); hipDeviceGetAttribute(&cus, hipDeviceAttributeMultiprocessorCount, dev);
        if (hipFuncSetAttribute((const void*)mega_fwd, hipFuncAttributeMaxDynamicSharedMemorySize, LDS_BYTES) != hipSuccess) { fprintf(stderr, "kernel_launch: hipFuncSetAttribute failed\n"); grid = -1; return; }
        if (hipOccupancyMaxActiveBlocksPerMultiprocessor(&per_cu, (const void*)mega_fwd, NTHREADS, LDS_BYTES) != hipSuccess || per_cu < 1) { fprintf(stderr, "kernel_launch: occupancy query says %d\n", per_cu); per_cu = 1; }
        (void)hipGetLastError();
        grid = cus;
    }
    if (grid < 0) return;
    hipMemsetAsync((char*)d_ws + WS_CTL, 0, CTL_BYTES, stream);
    Params p{};
    p.x = (const float*)d_in[0]; p.c = (const float*)d_in[1]; p.ctx = (const float*)d_in[2]; p.c_ctx = (const float*)d_in[3]; p.w_mod = (const float*)d_in[4]; p.b_mod = (const float*)d_in[5];
    p.norm_mix = (const float*)d_in[6]; p.w_in = (const float*)d_in[7]; p.sink = (const float*)d_in[8]; p.w_f = (const float*)d_in[9]; p.w_out = (const float*)d_in[10]; p.norm_ffn = (const float*)d_in[11];
    p.w_router = (const float*)d_in[12]; p.w_gate = (const float*)d_in[13]; p.w_up = (const float*)d_in[14]; p.w_down = (const float*)d_in[15]; p.norm_final = (const float*)d_in[16];
    p.out = (float*)d_out; p.ws = (unsigned char*)d_ws;
    void* args[] = {&p};
    hipError_t e = hipLaunchCooperativeKernel((const void*)mega_fwd, dim3(grid), dim3(NTHREADS), args, LDS_BYTES, stream);
    if (e != hipSuccess) fprintf(stderr, "kernel_launch: cooperative launch failed: %s (grid %d)\n", hipGetErrorString(e), grid);
}
```

```cpp
#include <hip/hip_runtime.h>
#include <hip/hip_cooperative_groups.h>
#include <cstdio>
#include <cstdint>
namespace cg = cooperative_groups;

#ifndef REP_P0
#define REP_P0 1
#endif
#ifndef REP_P1
#define REP_P1 1
#endif
#ifndef REP_P2
#define REP_P2 1
#endif
#ifndef REP_P3A
#define REP_P3A 1
#endif
#ifndef REP_P3B
#define REP_P3B 1
#endif
#ifndef REP_P4
#define REP_P4 1
#endif
#ifndef REP_P5
#define REP_P5 1
#endif
#ifndef REP_P6
#define REP_P6 1
#endif
#ifndef REP_P7
#define REP_P7 1
#endif
#ifndef REP_P8
#define REP_P8 1
#endif
#ifndef REP_P8B
#define REP_P8B 1
#endif
#ifndef REP_P9
#define REP_P9 1
#endif
#ifndef REP_P10
#define REP_P10 1
#endif
#ifndef REP_BAR
#define REP_BAR 1
#endif
#ifndef SELF_CHECK
#define SELF_CHECK 0
#endif

#define LAS __attribute__((address_space(3)))
#define GAS __attribute__((address_space(1)))
typedef unsigned short bf16_t;
typedef short bf16x8 __attribute__((ext_vector_type(8)));
typedef short s16x4 __attribute__((ext_vector_type(4)));
typedef float f32x2 __attribute__((ext_vector_type(2)));
typedef float f32x4 __attribute__((ext_vector_type(4)));
typedef float f32x16 __attribute__((ext_vector_type(16)));
typedef unsigned u32x2 __attribute__((ext_vector_type(2)));
typedef unsigned u32x4 __attribute__((ext_vector_type(4)));
typedef __bf16 bf16x2_t __attribute__((ext_vector_type(2)));

constexpr int DM = 2048, SEQ = 16384, CTXL = 256, NTOK = SEQ + CTXL;
constexpr int DIN = 2560, QD = 1024, KVD = 256, FD = 1024, NHEAD = 8, HD = 128;
constexpr int NE = 16, CAP = 2048, FF = 1024, NMOD = 6 * DM;
constexpr float RMS_EPS = 1e-6f;
constexpr float LOG2E = 1.4426950408889634f;
constexpr float QSCALE = 0.08838834764831845f * LOG2E;

constexpr size_t MiB = 1u << 20;
constexpr size_t WS_CTL = 0, CTL_BYTES = 1 * MiB;
constexpr size_t WS_MODP = 1 * MiB;
constexpr size_t WS_MODF = 3 * MiB;
constexpr size_t WS_F1 = 3 * MiB + 256 * 1024;
constexpr size_t WS_G2 = 3 * MiB + 512 * 1024;
constexpr size_t WS_TWC = 4 * MiB, WS_TWS = 4 * MiB + 64 * 1024;
constexpr size_t WS_ROPEC = 4 * MiB + 128 * 1024, WS_ROPES = 4 * MiB + 192 * 1024;
constexpr size_t WS_MGT = 5 * MiB;
constexpr size_t WS_AFF = 6 * MiB;
constexpr size_t WS_IDX = 7 * MiB;
constexpr size_t WS_GATE = 7 * MiB + 128 * 1024;
constexpr size_t WS_SLOT = 8 * MiB;
constexpr size_t WS_DBG = 9 * MiB;
constexpr size_t WS_WINT = 16 * MiB;
constexpr size_t WS_WOT = 27 * MiB;
constexpr size_t WS_WGU = 36 * MiB;
constexpr size_t WS_WD = 164 * MiB;
constexpr size_t WS_RA = 228 * MiB;
constexpr size_t WS_RB = 358 * MiB;
constexpr size_t WS_RC = 486 * MiB;
constexpr size_t WS_END = 550 * MiB;
constexpr size_t RA_HN = WS_RA, RA_HP = WS_RA + 65 * MiB, RA_T = WS_RA, RA_PQ = WS_RA + 64 * MiB, RA_GX = WS_RA, RA_OX = WS_RA + 64 * MiB, RA_HMID = WS_RC;
constexpr size_t RB_Q = WS_RB, RB_K = WS_RB + 32 * MiB, RB_VT = WS_RB + 41 * MiB, RB_UX = WS_RB + 50 * MiB, RB_XS = WS_RB, RB_SLAB = WS_RB;

constexpr int LDS_BYTES = 163840;
constexpr int LDS_CTL = 131072, LDS_GIDX = 131072 + 2048, LDS_VEC = 131072 + 8192;
constexpr int NWAVES = 8, NTHREADS = 512;

struct Params {
    const float *x, *c, *ctx, *c_ctx, *w_mod, *b_mod, *norm_mix, *w_in, *sink, *w_f, *w_out, *norm_ffn, *w_router, *w_gate, *w_up, *w_down, *norm_final;
    float* out; unsigned char* ws;
};

__device__ __forceinline__ unsigned pk2(float lo, float hi) { f32x2 v = {lo, hi}; bf16x2_t b = __builtin_convertvector(v, bf16x2_t); return __builtin_bit_cast(unsigned, b); }
__device__ __forceinline__ bf16_t f2bf(float f) { unsigned u = __builtin_bit_cast(unsigned, f); return (bf16_t)((u + 0x7fffu + ((u >> 16) & 1u)) >> 16); }
__device__ __forceinline__ float bf2f(bf16_t b) { return __builtin_bit_cast(float, ((unsigned)b) << 16); }
__device__ __forceinline__ u32x2 pk4(f32x4 v) { u32x2 r; r.x = pk2(v[0], v[1]); r.y = pk2(v[2], v[3]); return r; }
__device__ __forceinline__ float wave_sum(float v) {
#pragma unroll
    for (int o = 1; o < 64; o <<= 1) v += __shfl_xor(v, o);
    return v;
}
__device__ __forceinline__ float siluf(float v) { return v / (1.0f + __expf(-v)); }
#define LDS_WAIT() asm volatile("s_waitcnt lgkmcnt(0)" ::: "memory")

namespace pg8 {
constexpr int BM = 256, BK = 64, HALF = 128, HTB = HALF * BK * 2, STAGE_BYTES = 8 * HTB;
__device__ __forceinline__ int lds_byte(int r, int c) { const int st = (r >> 4) * 2 + (c >> 5), rr = r & 15, cc = c & 31, ob = rr * 64 + cc * 2; return st * 1024 + (ob ^ (((ob >> 9) & 1) << 5)); }
__device__ __forceinline__ void stage_rc(int b, int& R, int& C) { const int st = b / 1024, sb = b % 1024, swz = sb ^ (((sb >> 9) & 1) << 5); R = (st >> 1) * 16 + swz / 64; C = (st & 1) * 32 + (swz % 64) / 2; }

struct GUnit { const char* A; const char* B; int pm, pn, z; const int* gidx; };
__device__ __forceinline__ const char* uni_ptr(const char* p) { const unsigned long long v = (unsigned long long)p; const unsigned lo = __builtin_amdgcn_readfirstlane((unsigned)v), hi = __builtin_amdgcn_readfirstlane((unsigned)(v >> 32)); return (const char*)(((unsigned long long)hi << 32) | lo); }

template <class Epi, class Sched, bool GATHER = false>
__device__ __forceinline__ void gemm_phase(LAS unsigned char* lds, const int K, const int lda, const int ldb, const Sched& S, const Epi& E) {
    int tid_ = threadIdx.x; asm volatile("" : "+v"(tid_));
    const int tid = tid_, wid = __builtin_amdgcn_readfirstlane(tid >> 6), lane = tid & 63, wr = wid >> 2, wc = wid & 3, fr = lane & 15, fq = lane >> 4;
    const int nt = K / BK;
    unsigned voffA[2], voffB[2];
    int gR[2], gC[2];
#pragma unroll
    for (int i = 0; i < 2; ++i) { int R, C; stage_rc(tid * 16 + i * 8192, R, C); voffA[i] = (unsigned)(R * lda + C) * 2u; voffB[i] = (unsigned)(R * ldb + C) * 2u; gR[i] = R; gC[i] = C * 2; }
    const size_t hsA = GATHER ? 0 : (size_t)HALF * lda * 2, hsB = (size_t)HALF * ldb * 2;
    unsigned vA0[2], vA1[2], vN0[2], vN1[2];
    LAS int* gslot = (LAS int*)(lds + LDS_GIDX);
    const size_t kstep = (size_t)(BK * 2);
    const unsigned ldsw = (unsigned)wid * 1024u;
    const int aoff = lds_byte(wr * 64 + fr, fq * 8), boff = lds_byte(wc * 32 + fr, fq * 8);
#define PG8_SA(b, h) (((b) * 2 + (h)) * HTB)
#define PG8_SB(b, h) ((4 + (b) * 2 + (h)) * HTB)
#define PG8_STAGE(bufoff, gbase, voff) do { _Pragma("unroll") for (int _i = 0; _i < 2; ++_i) \
        __builtin_amdgcn_global_load_lds((const unsigned*)((const char*)(gbase) + (voff)[_i]), (LAS unsigned*)(lds + (bufoff) + ldsw + _i * 8192), 16, 0, 0); } while (0)
#define PG8_STAGE_A(bufoff, gbase, h, nx) do { if constexpr (GATHER) { if (nx) { if (h) PG8_STAGE(bufoff, gbase, vN1); else PG8_STAGE(bufoff, gbase, vN0); } else { if (h) PG8_STAGE(bufoff, gbase, vA1); else PG8_STAGE(bufoff, gbase, vA0); } } \
        else PG8_STAGE(bufoff, (gbase) + ((h) ? hsA : 0), voffA); } while (0)
#define PG8_LDA(dst, b, h) do { _Pragma("unroll") for (int m = 0; m < 4; ++m) _Pragma("unroll") for (int k = 0; k < 2; ++k) dst[m][k] = *(const LAS bf16x8*)(lds + PG8_SA(b, h) + aoff + m * 2048 + k * 1024); } while (0)
#define PG8_LDB(dst, b, h) do { _Pragma("unroll") for (int n = 0; n < 2; ++n) _Pragma("unroll") for (int k = 0; k < 2; ++k) dst[n][k] = *(const LAS bf16x8*)(lds + PG8_SB(b, h) + boff + n * 2048 + k * 1024); } while (0)
#define PG8_MMA(ai, bj, At, Bt) do { __builtin_amdgcn_s_setprio(1); _Pragma("unroll") for (int m = 0; m < 4; ++m) _Pragma("unroll") for (int n = 0; n < 2; ++n) _Pragma("unroll") for (int k = 0; k < 2; ++k) \
        acc[ai][bj][m][n] = __builtin_amdgcn_mfma_f32_16x16x32_bf16(Bt[n][k], At[m][k], acc[ai][bj][m][n], 0, 0, 0); __builtin_amdgcn_s_setprio(0); } while (0)
#define PG8_WAIT_V(n) asm volatile("s_waitcnt vmcnt(" #n ")" ::: "memory")
#define PG8_WAIT_L(n) asm volatile("s_waitcnt lgkmcnt(" #n ")" ::: "memory")
#define PG8_BAR __builtin_amdgcn_s_barrier()
#define PG8_SCHED __builtin_amdgcn_sched_barrier(0)
    GUnit cur, nxt; int ui = 0;
    if (!S.next(0, cur)) return;
    cur.A = uni_ptr(cur.A); cur.B = uni_ptr(cur.B); cur.pm = __builtin_amdgcn_readfirstlane(cur.pm); cur.pn = __builtin_amdgcn_readfirstlane(cur.pn); cur.z = __builtin_amdgcn_readfirstlane(cur.z); if constexpr (GATHER) cur.gidx = (const int*)uni_ptr((const char*)cur.gidx);
    asm volatile("" : "+s"(cur.A), "+s"(cur.B));
    f32x4 acc[2][2][4][2];
#pragma unroll
    for (int a = 0; a < 2; ++a)
#pragma unroll
        for (int b = 0; b < 2; ++b)
#pragma unroll
            for (int m = 0; m < 4; ++m)
#pragma unroll
                for (int n = 0; n < 2; ++n) acc[a][b][m][n] = (f32x4){0.f, 0.f, 0.f, 0.f};
    bf16x8 At[4][2], B0[2][2], B1[2][2];
    const char* cA = cur.A; const char* cB = cur.B;
    if constexpr (GATHER) {
        if (tid < 256) gslot[tid] = cur.gidx[tid];
        __syncthreads();
#pragma unroll
        for (int i = 0; i < 2; ++i) { vA0[i] = (unsigned)gslot[gR[i]] * (unsigned)(lda * 2) + gC[i]; vA1[i] = (unsigned)gslot[HALF + gR[i]] * (unsigned)(lda * 2) + gC[i]; vN0[i] = vA0[i]; vN1[i] = vA1[i]; }
    }
    PG8_STAGE(PG8_SB(0, 0), cB, voffB); PG8_STAGE(PG8_SB(0, 1), cB + hsB, voffB); PG8_STAGE_A(PG8_SA(0, 0), cA, 0, false); PG8_STAGE_A(PG8_SA(0, 1), cA, 1, false);
    if (wr == 1) PG8_BAR;
    PG8_WAIT_V(2); PG8_BAR;
    PG8_STAGE(PG8_SB(1, 0), cB + kstep, voffB); PG8_STAGE_A(PG8_SA(1, 0), cA + kstep, 0, false); PG8_STAGE(PG8_SB(1, 1), cB + hsB + kstep, voffB);
    PG8_WAIT_V(6); PG8_BAR;
    for (;;) {
        const bool has_next = S.next(ui + 1, nxt);
        nxt.A = uni_ptr(nxt.A); nxt.B = uni_ptr(nxt.B); nxt.pm = __builtin_amdgcn_readfirstlane(nxt.pm); nxt.pn = __builtin_amdgcn_readfirstlane(nxt.pn); nxt.z = __builtin_amdgcn_readfirstlane(nxt.z); if constexpr (GATHER) nxt.gidx = (const int*)uni_ptr((const char*)nxt.gidx);
        if (has_next) asm volatile("" : "+s"(nxt.A), "+s"(nxt.B));
        const char* nA = has_next ? nxt.A : cA; const char* nB = has_next ? nxt.B : cB;
        if constexpr (GATHER) {
            if (has_next && wid == 0) __builtin_amdgcn_global_load_lds((const unsigned*)(nxt.gidx + lane * 4), (LAS unsigned*)(gslot + ((ui + 1) & 1) * 256), 16, 0, 0);
        }
        for (int t = 0; t < nt; t += 2) {
            const bool last = (t == nt - 2);
            if constexpr (GATHER) { if (last && has_next) { const LAS int* sl = gslot + ((ui + 1) & 1) * 256;
#pragma unroll
                for (int i = 0; i < 2; ++i) { vN0[i] = (unsigned)sl[gR[i]] * (unsigned)(lda * 2) + gC[i]; vN1[i] = (unsigned)sl[HALF + gR[i]] * (unsigned)(lda * 2) + gC[i]; } } }
            const char* a1 = cA + (size_t)(t + 1) * kstep;
            const char* a2_ = last ? nA : cA + (size_t)(t + 2) * kstep; const char* b2_ = last ? nB : cB + (size_t)(t + 2) * kstep;
            const char* a2 = a2_; const char* b2 = b2_; const char* a3 = a2 + kstep; const char* b3 = b2 + kstep;
            asm volatile("" : "+s"(a1), "+s"(a2), "+s"(b2), "+s"(a3), "+s"(b3));
            PG8_LDB(B0, 0, 0); PG8_LDB(B1, 0, 1); PG8_SCHED; PG8_LDA(At, 0, 0); PG8_STAGE_A(PG8_SA(1, 1), a1, 1, false);
            PG8_WAIT_V(8); PG8_WAIT_L(0); PG8_BAR; PG8_MMA(0, 0, At, B0); PG8_MMA(0, 1, At, B1); PG8_BAR; PG8_SCHED;
            PG8_LDA(At, 0, 1); PG8_STAGE(PG8_SB(0, 0), b2, voffB); PG8_STAGE(PG8_SB(0, 1), b2 + hsB, voffB); PG8_STAGE_A(PG8_SA(0, 0), a2, 0, last);
            PG8_WAIT_V(8); PG8_WAIT_L(0); PG8_BAR; PG8_MMA(1, 0, At, B0); PG8_MMA(1, 1, At, B1); PG8_BAR; PG8_SCHED;
            PG8_LDB(B0, 1, 0); PG8_LDB(B1, 1, 1); PG8_SCHED; PG8_LDA(At, 1, 0); PG8_STAGE_A(PG8_SA(0, 1), a2, 1, last);
            PG8_WAIT_V(8); PG8_WAIT_L(0); PG8_BAR; PG8_MMA(0, 0, At, B0); PG8_MMA(0, 1, At, B1); PG8_BAR; PG8_SCHED;
            PG8_LDA(At, 1, 1); PG8_STAGE(PG8_SB(1, 0), b3, voffB); PG8_STAGE(PG8_SB(1, 1), b3 + hsB, voffB); PG8_STAGE_A(PG8_SA(1, 0), a3, 0, last);
            PG8_WAIT_V(8); PG8_WAIT_L(0); PG8_BAR; PG8_MMA(1, 0, At, B0); PG8_MMA(1, 1, At, B1); PG8_BAR; PG8_SCHED;
        }
        if (wr == 0) PG8_BAR;
        E(acc, cur, wr, wc, fr, fq);
        if (!has_next) break;
#pragma unroll
        for (int a = 0; a < 2; ++a)
#pragma unroll
            for (int b = 0; b < 2; ++b)
#pragma unroll
                for (int m = 0; m < 4; ++m)
#pragma unroll
                    for (int n = 0; n < 2; ++n) acc[a][b][m][n] = (f32x4){0.f, 0.f, 0.f, 0.f};
        cur = nxt; cA = nA; cB = nB; ++ui;
        if constexpr (GATHER) { vA0[0] = vN0[0]; vA0[1] = vN0[1]; vA1[0] = vN1[0]; vA1[1] = vN1[1]; }
        if (wr == 1) PG8_BAR;
    }
    PG8_WAIT_V(0);
    PG8_BAR;
#undef PG8_SA
#undef PG8_SB
#undef PG8_STAGE
#undef PG8_STAGE_A
#undef PG8_LDA
#undef PG8_LDB
#undef PG8_MMA
#undef PG8_WAIT_V
#undef PG8_WAIT_L
#undef PG8_BAR
#undef PG8_SCHED
}
}
using pg8::GUnit;
typedef f32x4 AccT[2][2][4][2];

__host__ __device__ __forceinline__ int rope_cprime(int d) { const int a = d >> 6, b = (d >> 5) & 1, i = d & 31; return 32 * (2 * a + (i >> 4)) + 16 * b + (i & 15); }

struct SchedP2 {
    const bf16_t *hn, *hp, *wint; int G, c;
    __device__ __forceinline__ bool next(int i, GUnit& u) const {
        int x, k;
        if (G == 256) { x = c & 7; k = i * 32 + (c >> 3); if (k >= 81 || (k == 80 && x >= 2)) return false; }
        else { const int L = i * G + c; if (L >= 642) return false; if (L >= 640) { x = L - 640; k = 80; } else { x = L / 80; k = L % 80; } }
        if (k < 40) { u.z = 0; u.pm = 8 * x + k / 5; u.pn = k % 5; }
        else if (k < 48) { u.z = 1; u.pm = 0; u.pn = 8 * x + (k - 40); }
        else if (k < 80) { u.z = 2; u.pm = (k - 48) & 3; u.pn = 8 * x + ((k - 48) >> 2); }
        else if (x == 0) { u.z = 0; u.pm = 64; u.pn = 4; }
        else { u.z = 1; u.pm = 0; u.pn = 64; }
        if (u.z == 0) { u.A = (const char*)(hn + (size_t)u.pm * 256 * DM); u.B = (const char*)(wint + (size_t)u.pn * 256 * DM); }
        else if (u.z == 1) { u.A = (const char*)(wint + (size_t)1280 * DM); u.B = (const char*)(hn + (size_t)u.pn * 256 * DM); }
        else { u.A = (const char*)(wint + (size_t)(1536 + 256 * u.pm) * DM); u.B = (const char*)(hp + (size_t)u.pn * 256 * DM); }
        return true;
    }
};
struct SchedSimple {
    const char *A, *B; int nM, nN, nZ, G, c; size_t aTile, bTile, aZ, bZ;
    __device__ __forceinline__ bool next(int i, GUnit& u) const {
        const int U = nM * nN * nZ; int L;
        if (G == 256 && (U & 7) == 0) { const int per = U >> 3, k = i * 32 + (c >> 3); if (k >= per) return false; L = (c & 7) * per + k; }
        else { L = i * G + c; if (L >= U) return false; }
        const int per = nM * nN; u.z = L / per; const int r = L % per; u.pm = r / nN; u.pn = r % nN;
        u.A = A + (size_t)u.z * aZ + (size_t)u.pm * aTile; u.B = B + (size_t)u.z * bZ + (size_t)u.pn * bTile; return true;
    }
};

struct SchedUP {
    const char* gx; const char* wgu; const int* idx; int G, c;
    __device__ __forceinline__ bool next(int i, GUnit& u) const {
        int L;
        if (G == 256) { const int k = i * 32 + (c >> 3); if (k >= 128) return false; L = (c & 7) * 128 + k; } else { L = i * G + c; if (L >= 1024) return false; }
        u.z = L >> 6; const int r = L & 63; u.pm = r >> 3; u.pn = r & 7;
        u.A = gx; u.gidx = idx + u.z * CAP + u.pm * 256; u.B = wgu + ((size_t)u.z * 2048 + (size_t)u.pn * 256) * DM * 2; return true;
    }
};

struct EpiP2 {
    bf16_t *Q, *Kb, *Vt, *Ux; const float *ropeC, *ropeS;
    __device__ __forceinline__ void operator()(const AccT& acc, const GUnit& u, int wr, int wc, int fr, int fq) const {
        if (u.z == 0) {
            const int a = wc >> 1, i0 = (wc & 1) * 16 + 4 * fq;
#pragma unroll
            for (int ai = 0; ai < 2; ++ai)
#pragma unroll
                for (int m = 0; m < 4; ++m) {
                    const int row = 256 * u.pm + 128 * ai + 64 * wr + 16 * m + fr;
                    const bool isctx = row >= SEQ;
                    f32x4 c4 = (f32x4){1.f, 1.f, 1.f, 1.f}, s4 = (f32x4){0.f, 0.f, 0.f, 0.f};
                    if (!isctx) { const int pos = a ? (row & 63) : (row >> 6); c4 = *(const f32x4*)(ropeC + pos * 32 + i0); s4 = *(const f32x4*)(ropeS + pos * 32 + i0); }
#pragma unroll
                    for (int bj = 0; bj < 2; ++bj) {
                        const int hcol = u.pn * 2 + bj;
                        const f32x4 x0 = acc[ai][bj][m][0], x1 = acc[ai][bj][m][1];
                        f32x4 o0 = x0 * c4 - x1 * s4, o1 = x1 * c4 + x0 * s4;
                        if (hcol < 8) { if (!isctx) { o0 = o0 * QSCALE; o1 = o1 * QSCALE; bf16_t* p = Q + (size_t)row * QD + hcol * 128 + 64 * a + i0; *(u32x2*)p = pk4(o0); *(u32x2*)(p + 32) = pk4(o1); } }
                        else { bf16_t* p = Kb + (size_t)row * KVD + (hcol - 8) * 128 + 64 * a + i0; *(u32x2*)p = pk4(o0); *(u32x2*)(p + 32) = pk4(o1); }
                    }
                }
        } else {
            bf16_t* base = (u.z == 1) ? Vt : Ux + (size_t)u.pm * 256 * SEQ;
            const int ld = (u.z == 1) ? NTOK : SEQ;
#pragma unroll
            for (int ai = 0; ai < 2; ++ai)
#pragma unroll
                for (int m = 0; m < 4; ++m) {
                    const int ch = 128 * ai + 64 * wr + 16 * m + fr;
                    bf16_t* rowp = base + (size_t)ch * ld + 256 * u.pn + 32 * wc + 4 * fq;
#pragma unroll
                    for (int bj = 0; bj < 2; ++bj)
#pragma unroll
                        for (int n = 0; n < 2; ++n) *(u32x2*)(rowp + 128 * bj + 16 * n) = pk4(acc[ai][bj][m][n]);
                }
        }
    }
};
struct EpiFFT1 {
    bf16_t* T; const float *twc, *tws;
    __device__ __forceinline__ void operator()(const AccT& acc, const GUnit& u, int wr, int wc, int fr, int fq) const {
#pragma unroll
        for (int m = 0; m < 4; ++m) {
            const int k1 = 64 * wr + 16 * m + fr;
#pragma unroll
            for (int n = 0; n < 2; ++n) {
                const int n2 = 32 * wc + 16 * n + 4 * fq;
                const f32x4 c4 = *(const f32x4*)(twc + k1 * 128 + n2), s4 = *(const f32x4*)(tws + k1 * 128 + n2);
#pragma unroll
                for (int bj = 0; bj < 2; ++bj) {
                    const int j = 2 * u.pn + bj;
                    const f32x4 re = acc[0][bj][m][n], im = acc[1][bj][m][n];
                    const f32x4 ro = re * c4 + im * s4, io = im * c4 - re * s4;
                    bf16_t* p = T + ((size_t)(k1 * 1024 + j) * 2) * 128 + n2;
                    *(u32x2*)p = pk4(ro); *(u32x2*)(p + 128) = pk4(io);
                }
                asm volatile("" ::: "memory");
            }
        }
    }
};
struct EpiFFT2 {
    bf16_t* PQ;
    __device__ __forceinline__ void operator()(const AccT& acc, const GUnit& u, int wr, int wc, int fr, int fq) const {
        const int k1 = u.pn >> 2, g = u.pn & 3;
#pragma unroll
        for (int ai = 0; ai < 2; ++ai)
#pragma unroll
            for (int m = 0; m < 4; ++m) {
                const int k2 = 64 * wr + 16 * m + fr;
                bf16_t* rowp = PQ + (size_t)(k1 + 128 * k2) * DM + g * 512 + ai * 256 + 32 * wc + 4 * fq;
#pragma unroll
                for (int bj = 0; bj < 2; ++bj)
#pragma unroll
                    for (int n = 0; n < 2; ++n) *(u32x2*)(rowp + 128 * bj + 16 * n) = pk4(acc[ai][bj][m][n]);
            }
    }
};
struct EpiFMIX {
    bf16_t* mix;
    __device__ __forceinline__ void operator()(const AccT& acc, const GUnit& u, int wr, int wc, int fr, int fq) const {
#pragma unroll
        for (int ai = 0; ai < 2; ++ai)
#pragma unroll
            for (int m = 0; m < 4; ++m) {
                const int row = 256 * u.pm + 128 * ai + 64 * wr + 16 * m + fr;
                bf16_t* rowp = mix + (size_t)row * DM + 1024 + u.z * 256 + 32 * wc + 4 * fq;
#pragma unroll
                for (int bj = 0; bj < 2; ++bj)
#pragma unroll
                    for (int n = 0; n < 2; ++n) *(u32x2*)(rowp + 128 * bj + 16 * n) = pk4(acc[ai][bj][m][n]);
            }
    }
};
struct EpiOUT {
    bf16_t* ox;
    __device__ __forceinline__ void operator()(const AccT& acc, const GUnit& u, int wr, int wc, int fr, int fq) const {
#pragma unroll
        for (int ai = 0; ai < 2; ++ai)
#pragma unroll
            for (int m = 0; m < 4; ++m) {
                const int row = 256 * u.pm + 128 * ai + 64 * wr + 16 * m + fr;
                bf16_t* rowp = ox + (size_t)row * DM + 256 * u.pn + 32 * wc + 4 * fq;
#pragma unroll
                for (int bj = 0; bj < 2; ++bj)
#pragma unroll
                    for (int n = 0; n < 2; ++n) *(u32x2*)(rowp + 128 * bj + 16 * n) = pk4(acc[ai][bj][m][n]);
            }
    }
};
struct EpiUP {
    bf16_t* hmid;
    __device__ __forceinline__ void operator()(const AccT& acc, const GUnit& u, int wr, int wc, int fr, int fq) const {
#pragma unroll
        for (int ai = 0; ai < 2; ++ai)
#pragma unroll
            for (int m = 0; m < 4; ++m) {
                const int row = u.z * CAP + 256 * u.pm + 128 * ai + 64 * wr + 16 * m + fr;
                bf16_t* rowp = hmid + (size_t)row * FF + 128 * u.pn + 32 * wc + 4 * fq;
#pragma unroll
                for (int n = 0; n < 2; ++n) { const f32x4 gv = acc[ai][0][m][n], uv = acc[ai][1][m][n]; f32x4 h;
#pragma unroll
                    for (int e = 0; e < 4; ++e) h[e] = siluf(gv[e]) * uv[e];
                    *(u32x2*)(rowp + 16 * n) = pk4(h); }
            }
    }
};
struct EpiDOWN {
    bf16_t* slab; const float* gate;
    __device__ __forceinline__ void operator()(const AccT& acc, const GUnit& u, int wr, int wc, int fr, int fq) const {
#pragma unroll
        for (int ai = 0; ai < 2; ++ai)
#pragma unroll
            for (int m = 0; m < 4; ++m) {
                const int row = u.z * CAP + 256 * u.pm + 128 * ai + 64 * wr + 16 * m + fr;
                const float gt = gate[row];
                bf16_t* rowp = slab + (size_t)row * DM + 256 * u.pn + 32 * wc + 4 * fq;
#pragma unroll
                for (int bj = 0; bj < 2; ++bj)
#pragma unroll
                    for (int n = 0; n < 2; ++n) *(u32x2*)(rowp + 128 * bj + 16 * n) = pk4(acc[ai][bj][m][n] * gt);
            }
    }
};

struct Frame { LAS unsigned char* lds; int tid, lane, wave, G, vcu, gw, NGW; };

__device__ __forceinline__ void p0_mod_item(const Params& P, float* modp, int item, int lane) {
    const int kc = item / 48, nc = item % 48;
    const float cx0 = P.c[128 * kc + lane], cx1 = P.c[128 * kc + 64 + lane], cc0 = P.c_ctx[128 * kc + lane], cc1 = P.c_ctx[128 * kc + 64 + lane];
    const float sx0 = siluf(cx0), sx1 = siluf(cx1), sc0 = siluf(cc0), sc1 = siluf(cc1);
    f32x4 ax = (f32x4){0.f, 0.f, 0.f, 0.f}, ac = ax;
    const float* wp = P.w_mod + (size_t)(128 * kc) * NMOD + 256 * nc + 4 * lane;
#pragma unroll 8
    for (int k = 0; k < 64; ++k) { const f32x4 w = *(const f32x4*)(wp + (size_t)k * NMOD); const float sx = __shfl(sx0, k), sc = __shfl(sc0, k); ax += w * sx; ac += w * sc; }
#pragma unroll 8
    for (int k = 0; k < 64; ++k) { const f32x4 w = *(const f32x4*)(wp + (size_t)(64 + k) * NMOD); const float sx = __shfl(sx1, k), sc = __shfl(sc1, k); ax += w * sx; ac += w * sc; }
    *(f32x4*)(modp + (size_t)(kc * 2 + 0) * NMOD + 256 * nc + 4 * lane) = ax;
    *(f32x4*)(modp + (size_t)(kc * 2 + 1) * NMOD + 256 * nc + 4 * lane) = ac;
}
template <class RowMap>
__device__ __forceinline__ void p0_transpose_item(const float* W, int K, int N, bf16_t* WT, const RowMap& rm, LAS float* scr, int item, int lane) {
    const int nblk = N / 32, kb = item / nblk, nb = item % nblk, k0 = 64 * kb, n0 = 32 * nb;
#pragma unroll 8
    for (int i = 0; i < 32; ++i) { const int kk = 2 * i + (lane >> 5); scr[kk * 33 + (lane & 31)] = W[(size_t)(k0 + kk) * N + n0 + (lane & 31)]; }
    LDS_WAIT();
    const int c = lane & 7;
#pragma unroll
    for (int j = 0; j < 4; ++j) { const int n = (lane >> 3) + 8 * j; const LAS float* s = scr + (8 * c) * 33 + n;
        u32x4 o; o.x = pk2(s[0 * 33], s[1 * 33]); o.y = pk2(s[2 * 33], s[3 * 33]); o.z = pk2(s[4 * 33], s[5 * 33]); o.w = pk2(s[6 * 33], s[7 * 33]);
        *(u32x4*)(WT + (size_t)rm(n0 + n) * K + k0 + 8 * c) = o; }
    LDS_WAIT();
}
struct RmIdent { int off; __device__ __forceinline__ int operator()(int n) const { return off + n; } };
struct RmWin { __device__ __forceinline__ int operator()(int n) const { if (n >= 1280) return n; return (n & ~127) + rope_cprime(n & 127); } };
struct RmGU { int up; __device__ __forceinline__ int operator()(int f) const { return 256 * (f >> 7) + 128 * up + (f & 127); } };

__device__ __forceinline__ void p0_prep(const Frame& F, const Params& P) {
    unsigned char* ws = P.ws;
    LAS float* scr = (LAS float*)(F.lds + F.wave * 16384);
    constexpr int I_MOD = 768;
    constexpr int I_WIN = (DM / 64) * (DIN / 32);
    constexpr int I_WOUT = (DM / 64) * (DM / 32);
    constexpr int I_GU = (DM / 64) * (FF / 32);
    constexpr int I_DN = (FF / 64) * (DM / 32);
    constexpr int I_TAB = 32 + 64 + 16 + 8;
    constexpr int I_MGT = 2048;
    constexpr int NITEMS = I_MOD + I_WIN + I_WOUT + NE * (2 * I_GU + I_DN) + I_TAB + I_MGT;
    bf16_t* wint = (bf16_t*)(ws + WS_WINT); bf16_t* wot = (bf16_t*)(ws + WS_WOT); bf16_t* wgu = (bf16_t*)(ws + WS_WGU); bf16_t* wd = (bf16_t*)(ws + WS_WD);
    for (int it = F.gw; it < NITEMS; it += F.NGW) {
        int r = it;
        if (r < I_MOD) { p0_mod_item(P, (float*)(ws + WS_MODP), r, F.lane); continue; } r -= I_MOD;
        if (r < I_WIN) { p0_transpose_item(P.w_in, DM, DIN, wint, RmWin{}, scr, r, F.lane); continue; } r -= I_WIN;
        if (r < I_WOUT) { p0_transpose_item(P.w_out, DM, DM, wot, RmIdent{0}, scr, r, F.lane); continue; } r -= I_WOUT;
        if (r < NE * 2 * I_GU) { const int e = r / (2 * I_GU), q = r % (2 * I_GU), up = q / I_GU, ii = q % I_GU;
            p0_transpose_item((up ? P.w_up : P.w_gate) + (size_t)e * DM * FF, DM, FF, wgu + (size_t)e * 2048 * DM, RmGU{up}, scr, ii, F.lane); continue; } r -= NE * 2 * I_GU;
        if (r < NE * I_DN) { const int e = r / I_DN, ii = r % I_DN; p0_transpose_item(P.w_down + (size_t)e * FF * DM, FF, DM, wd + (size_t)e * DM * FF, RmIdent{0}, scr, ii, F.lane); continue; } r -= NE * I_DN;
        if (r < I_TAB) {
            for (int q = 0; q < 16; ++q) {
                const int el = r * 1024 + q * 64 + F.lane;
                if (el < 32768) {
                    const int row = el >> 7, n1 = el & 127, k1 = row & 127, reim = row >> 7; const int ph = (k1 * n1) & 127;
                    const float v = reim ? -sinpif((float)ph * (1.0f / 64.0f)) : cospif((float)ph * (1.0f / 64.0f));
                    ((bf16_t*)(ws + WS_F1))[el] = f2bf(v);
                } else if (el < 32768 + 65536) {
                    const int e2 = el - 32768, row = e2 >> 8, col = e2 & 255, pq = row >> 7, k2 = row & 127, reim = col >> 7, n2 = col & 127; const int ph = (k2 * n2) & 127;
                    const float cs = cospif((float)ph * (1.0f / 64.0f)), sn = sinpif((float)ph * (1.0f / 64.0f));
                    const float v = (pq == 0) ? (reim == 0 ? cs : sn) : (reim == 0 ? sn : -cs);
                    ((bf16_t*)(ws + WS_G2))[e2] = f2bf(v);
                } else if (el < 32768 + 65536 + 16384) {
                    const int e2 = el - 32768 - 65536, k1 = e2 >> 7, n2 = e2 & 127; const float ph = (float)(k1 * n2) * (1.0f / 8192.0f);
                    ((float*)(ws + WS_TWC))[e2] = cospif(ph); ((float*)(ws + WS_TWS))[e2] = sinpif(ph);
                } else {
                    const int e2 = el - 32768 - 65536 - 16384, pos = e2 >> 5, i = e2 & 31;
                    const double fr = pow(10000.0, -(double)i / 32.0), ang = (double)pos * fr;
                    ((float*)(ws + WS_ROPEC))[e2] = (float)cos(ang); ((float*)(ws + WS_ROPES))[e2] = (float)sin(ang);
                }
            }
            continue;
        } r -= I_TAB;
        {
            LAS float* ctab = scr;
            for (int q = 0; q < 4; ++q) ctab[q * 64 + F.lane] = cospif((float)(q * 64 + F.lane) * (1.0f / 128.0f));
            LDS_WAIT();
            const int g = r >> 9, d = (r >> 1) & 255, pq = r & 1;
            const float* wf = P.w_f + (size_t)g * 256 * 256 + d;
            float a0 = 0.f, a1 = 0.f, a2 = 0.f, a3 = 0.f;
            for (int m = 0; m < 256; ++m) {
                const float w = wf[(size_t)m * 256];
                const int sh = pq ? 64 : 0;
                a0 += w * ctab[(m * (F.lane) + sh) & 255];
                a1 += w * ctab[(m * (F.lane + 64) + sh) & 255];
                a2 += w * ctab[(m * (F.lane + 128) + sh) & 255];
                a3 += w * ctab[(m * (F.lane + 192) + sh) & 255];
            }
            bf16_t* o = (bf16_t*)(ws + WS_MGT) + ((size_t)(g * 256 + d)) * 512 + pq * 256 + F.lane;
            o[0] = f2bf(a0 * (1.0f / 2048.0f)); o[64] = f2bf(a1 * (1.0f / 2048.0f)); o[128] = f2bf(a2 * (1.0f / 2048.0f)); o[192] = f2bf(a3 * (1.0f / 2048.0f));
            LDS_WAIT();
        }
    }
}

__device__ __forceinline__ float mod_final(const float* modp, const float* b_mod, int which, int col) {
    const float* p = modp + (size_t)which * NMOD + col;
    float t[16];
#pragma unroll
    for (int kc = 0; kc < 16; ++kc) t[kc] = p[(size_t)kc * 2 * NMOD];
    float s = b_mod[col];
#pragma unroll
    for (int kc = 0; kc < 16; ++kc) s += t[kc];
    return s;
}
__device__ __forceinline__ void p1_norm(const Frame& F, const Params& P) {
    unsigned char* ws = P.ws;
    const float* modp = (const float*)(ws + WS_MODP);
    LAS float* Ax = (LAS float*)F.lds; LAS float* Bx = Ax + DM; LAS float* Ac = Bx + DM; LAS float* Bc = Ac + DM;
#pragma unroll 1
    for (int k = F.tid; k < DM; k += NTHREADS) {
        const float g = P.norm_mix[k];
        const float s0 = mod_final(modp, P.b_mod, 0, DM + k), h0 = mod_final(modp, P.b_mod, 0, k);
        Ax[k] = g * (1.0f + s0); Bx[k] = h0;
        asm volatile("" ::: "memory");
        const float s1 = mod_final(modp, P.b_mod, 1, DM + k), h1 = mod_final(modp, P.b_mod, 1, k);
        Ac[k] = g * (1.0f + s1); Bc[k] = h1;
        asm volatile("" ::: "memory");
    }
    float* modf = (float*)(ws + WS_MODF);
    for (int col = blockIdx.x * NTHREADS + F.tid; col < NMOD; col += F.G * NTHREADS) modf[col] = mod_final(modp, P.b_mod, 0, col);
    __syncthreads();
    bf16_t* hn = (bf16_t*)(ws + RA_HN); bf16_t* hp = (bf16_t*)(ws + RA_HP);
    for (int g4 = F.gw; g4 < NTOK / 4; g4 += F.NGW) {
        asm volatile("" ::: "memory");
        const int r0 = 4 * g4; const bool isx = r0 < SEQ;
        const float* src = isx ? P.x + (size_t)r0 * DM : P.ctx + (size_t)(r0 - SEQ) * DM;
        const LAS float* A = isx ? Ax : Ac; const LAS float* B = isx ? Bx : Bc;
        f32x4 v[4][8]; float ss[4];
#pragma unroll
        for (int q = 0; q < 4; ++q)
#pragma unroll
            for (int j = 0; j < 8; ++j) v[q][j] = *(const f32x4*)(src + (size_t)q * DM + 256 * j + 4 * F.lane);
#pragma unroll
        for (int q = 0; q < 4; ++q) { float a = 0.f;
#pragma unroll
            for (int j = 0; j < 8; ++j) a += (v[q][j][0] * v[q][j][0] + v[q][j][1] * v[q][j][1]) + (v[q][j][2] * v[q][j][2] + v[q][j][3] * v[q][j][3]);
            ss[q] = a; }
#pragma unroll
        for (int o = 1; o < 64; o <<= 1) {
#pragma unroll
            for (int q = 0; q < 4; ++q) ss[q] += __shfl_xor(ss[q], o); }
#pragma unroll
        for (int q = 0; q < 4; ++q) {
            const int r = r0 + q; const float rs = rsqrtf(ss[q] * (1.0f / DM) + RMS_EPS);
            bf16_t* d0 = hn + (size_t)r * DM; bf16_t* d1 = hp + (size_t)((r & 127) * 128 + (r >> 7)) * DM;
#pragma unroll
            for (int j = 0; j < 8; ++j) { const int k = 256 * j + 4 * F.lane; const f32x4 a = *(const LAS f32x4*)(A + k), b = *(const LAS f32x4*)(B + k);
                const u32x2 o = pk4(v[q][j] * rs * a + b); *(u32x2*)(d0 + k) = o; if (isx) *(u32x2*)(d1 + k) = o; }
        }
    }
}

constexpr int AT_KB = 16384, AT_VB = 128 * 136, AT_BUF = AT_KB + AT_VB;
__device__ __forceinline__ void attn_item(const Frame& F, int item, const bf16_t* Q, const bf16_t* Kb, const bf16_t* Vt, bf16_t* mix, const float* sink) {
    const int qb = item >> 1, kvh = item & 1, q0 = qb * 64;
    const int tid = F.tid, lane = F.lane, wid = F.wave, head = kvh * 4 + (wid >> 1), sb = wid & 1, r32 = lane & 31, hi = lane >> 5;
    const int qrow = q0 + 32 * sb + r32;
    bf16x8 qf[8];
#pragma unroll
    for (int s = 0; s < 8; ++s) qf[s] = *(const bf16x8*)(Q + (size_t)qrow * QD + head * 128 + 16 * s + 8 * hi);
    float mrun = sink[head] * LOG2E, lrun = hi ? 0.f : 1.f;
    f32x16 o[4];
#pragma unroll
    for (int d = 0; d < 4; ++d)
#pragma unroll
        for (int r = 0; r < 16; ++r) o[d][r] = 0.f;
    int lt_lo = 0, lt_hi = 4;
    if (q0 - 128 < 0) lt_lo = (128 - q0) / 64;
    if (q0 - 128 + 64 * 4 >= SEQ) lt_hi = (SEQ - 1 - (q0 - 128)) / 64;
    const int nloc = lt_hi - lt_lo + 1, ntile = nloc + 4;
    u32x4 kreg[2], vreg[2];
    auto tile_start = [&](int t) -> int { return t < nloc ? (q0 - 128 + 64 * (lt_lo + t)) : (SEQ + 64 * (t - nloc)); };
    auto gload = [&](int t) {
        const int ks = tile_start(t);
#pragma unroll
        for (int i = 0; i < 2; ++i) { const int c = tid + 512 * i;
            kreg[i] = *(const u32x4*)(Kb + (size_t)(ks + (c >> 4)) * KVD + kvh * 128 + (c & 15) * 8);
            vreg[i] = *(const u32x4*)(Vt + (size_t)(kvh * 128 + (c >> 3)) * NTOK + ks + (c & 7) * 8); }
    };
    auto lwrite = [&](int buf) {
        LAS unsigned char* kb = F.lds + buf * AT_BUF; LAS unsigned char* vb = kb + AT_KB;
#pragma unroll
        for (int i = 0; i < 2; ++i) { const int c = tid + 512 * i; const int row = c >> 4, ch = c & 15;
            *(LAS u32x4*)(kb + row * 256 + ((ch ^ (row & 15)) << 4)) = kreg[i];
            const int dr = c >> 3, vc = c & 7; LAS unsigned char* vp = vb + dr * 136 + vc * 16;
            *(LAS u32x2*)vp = (u32x2){vreg[i].x, vreg[i].y}; *(LAS u32x2*)(vp + 8) = (u32x2){vreg[i].z, vreg[i].w}; }
    };
    gload(0); lwrite(0); __syncthreads();
    for (int t = 0; t < ntile; ++t) {
        if (t + 1 < ntile) gload(t + 1);
        const LAS unsigned char* kb = F.lds + (t & 1) * AT_BUF; const LAS unsigned char* vb = kb + AT_KB;
        f32x16 p0, p1;
#pragma unroll
        for (int r = 0; r < 16; ++r) { p0[r] = 0.f; p1[r] = 0.f; }
#pragma unroll
        for (int s = 0; s < 8; ++s) {
            const int ch = 2 * s + hi;
            const bf16x8 a0 = *(const LAS bf16x8*)(kb + r32 * 256 + ((ch ^ (r32 & 15)) << 4));
            const bf16x8 a1 = *(const LAS bf16x8*)(kb + (32 + r32) * 256 + ((ch ^ (r32 & 15)) << 4));
            p0 = __builtin_amdgcn_mfma_f32_32x32x16_bf16(a0, qf[s], p0, 0, 0, 0);
            p1 = __builtin_amdgcn_mfma_f32_32x32x16_bf16(a1, qf[s], p1, 0, 0, 0);
        }
        if (t < nloc) {
            const int lt = lt_lo + t, ks = q0 - 128 + 64 * lt;
            if (lt == 0 || lt == 4) {
#pragma unroll
                for (int r = 0; r < 16; ++r) { const int key = ks + (r & 3) + 8 * (r >> 2) + 4 * hi; int d0 = qrow - key; d0 = d0 < 0 ? -d0 : d0; int d1 = qrow - (key + 32); d1 = d1 < 0 ? -d1 : d1;
                    if (d0 > 128) p0[r] = -1e30f; if (d1 > 128) p1[r] = -1e30f; }
            }
        }
        float mx = p0[0];
#pragma unroll
        for (int r = 1; r < 16; ++r) mx = fmaxf(mx, p0[r]);
#pragma unroll
        for (int r = 0; r < 16; ++r) mx = fmaxf(mx, p1[r]);
        mx = fmaxf(mx, __shfl_xor(mx, 32));
        const float mnew = fmaxf(mrun, mx), alpha = exp2f(mrun - mnew);
        mrun = mnew;
        float ls = 0.f;
#pragma unroll
        for (int r = 0; r < 16; ++r) { p0[r] = exp2f(p0[r] - mnew); p1[r] = exp2f(p1[r] - mnew); ls += p0[r] + p1[r]; }
        lrun = lrun * alpha + ls;
#pragma unroll
        for (int d = 0; d < 4; ++d)
#pragma unroll
            for (int r = 0; r < 16; ++r) o[d][r] *= alpha;
        bf16x8 pk[4];
#pragma unroll
        for (int s = 0; s < 2; ++s) {
            u32x4 w0, w1;
            w0.x = pk2(p0[8 * s + 0], p0[8 * s + 1]); w0.y = pk2(p0[8 * s + 2], p0[8 * s + 3]); w0.z = pk2(p0[8 * s + 4], p0[8 * s + 5]); w0.w = pk2(p0[8 * s + 6], p0[8 * s + 7]);
            w1.x = pk2(p1[8 * s + 0], p1[8 * s + 1]); w1.y = pk2(p1[8 * s + 2], p1[8 * s + 3]); w1.z = pk2(p1[8 * s + 4], p1[8 * s + 5]); w1.w = pk2(p1[8 * s + 6], p1[8 * s + 7]);
            pk[s] = __builtin_bit_cast(bf16x8, w0); pk[2 + s] = __builtin_bit_cast(bf16x8, w1);
        }
#pragma unroll
        for (int d = 0; d < 4; ++d) {
            const LAS unsigned char* vrow = vb + (32 * d + r32) * 136;
#pragma unroll
            for (int ks = 0; ks < 4; ++ks) {
                const u32x2 lo = *(const LAS u32x2*)(vrow + (16 * ks + 4 * hi) * 2), hi2 = *(const LAS u32x2*)(vrow + (16 * ks + 8 + 4 * hi) * 2);
                const u32x4 av = (u32x4){lo.x, lo.y, hi2.x, hi2.y};
                o[d] = __builtin_amdgcn_mfma_f32_32x32x16_bf16(__builtin_bit_cast(bf16x8, av), pk[ks], o[d], 0, 0, 0);
            }
        }
        if (t + 1 < ntile) lwrite((t + 1) & 1);
        __syncthreads();
    }
    const float ltot = lrun + __shfl_xor(lrun, 32), inv = 1.0f / ltot;
    bf16_t* orow = mix + (size_t)qrow * DM + head * 128;
#pragma unroll
    for (int d = 0; d < 4; ++d)
#pragma unroll
        for (int g = 0; g < 4; ++g) {
            const f32x4 v = (f32x4){o[d][4 * g] * inv, o[d][4 * g + 1] * inv, o[d][4 * g + 2] * inv, o[d][4 * g + 3] * inv};
            *(u32x2*)(orow + 32 * d + 8 * g + 4 * hi) = pk4(v);
        }
}

__device__ __forceinline__ f32x4 bf4_to_f32(u32x2 w) { return (f32x4){__builtin_bit_cast(float, w.x << 16), __builtin_bit_cast(float, w.x & 0xffff0000u), __builtin_bit_cast(float, w.y << 16), __builtin_bit_cast(float, w.y & 0xffff0000u)}; }
__device__ __forceinline__ void p7_router(const Frame& F, const Params& P) {
    unsigned char* ws = P.ws;
    const float* modf = (const float*)(ws + WS_MODF);
    LAS float* wr = (LAS float*)F.lds;
    LAS float* Av = (LAS float*)(F.lds + LDS_VEC); LAS float* Bv = Av + DM; LAS float* M2 = Bv + DM;
    {
        f32x4 wv[16];
#pragma unroll
        for (int i = 0; i < 16; ++i) wv[i] = *(const f32x4*)(P.w_router + (size_t)(i * NTHREADS + F.tid) * 4);
#pragma unroll
        for (int i = 0; i < 16; ++i) { const int q = i * NTHREADS + F.tid, k = q >> 2, e0 = (q & 3) * 4;
            wr[(e0 + 0) * DM + k] = wv[i][0]; wr[(e0 + 1) * DM + k] = wv[i][1]; wr[(e0 + 2) * DM + k] = wv[i][2]; wr[(e0 + 3) * DM + k] = wv[i][3]; }
    }
    {   float nv[4], m4[4], m3[4], m2[4];
#pragma unroll
        for (int i = 0; i < 4; ++i) { const int k = i * NTHREADS + F.tid; nv[i] = P.norm_ffn[k]; m4[i] = modf[4 * DM + k]; m3[i] = modf[3 * DM + k]; m2[i] = modf[2 * DM + k]; }
#pragma unroll
        for (int i = 0; i < 4; ++i) { const int k = i * NTHREADS + F.tid; Av[k] = nv[i] * (1.0f + m4[i]); Bv[k] = m3[i]; M2[k] = m2[i]; }
    }
    __syncthreads();
    bf16_t* gx = (bf16_t*)(ws + RA_GX); float* aff = (float*)(ws + WS_AFF); const bf16_t* ox = (const bf16_t*)(ws + RA_OX);
    for (int r0 = 2 * F.gw; r0 < SEQ; r0 += 2 * F.NGW) {
        asm volatile("" ::: "memory");
        f32x4 v[2][8]; u32x2 ow[2][8];
#pragma unroll
        for (int q = 0; q < 2; ++q)
#pragma unroll
            for (int j = 0; j < 8; ++j) { const size_t o = (size_t)(r0 + q) * DM + 256 * j + 4 * F.lane; v[q][j] = *(const f32x4*)(P.x + o); ow[q][j] = *(const u32x2*)(ox + o); }
        float ss[2];
#pragma unroll
        for (int q = 0; q < 2; ++q) { float a = 0.f;
#pragma unroll
            for (int j = 0; j < 8; ++j) { const f32x4 m2 = *(const LAS f32x4*)(M2 + 256 * j + 4 * F.lane); v[q][j] = v[q][j] + m2 * bf4_to_f32(ow[q][j]);
                a += (v[q][j][0] * v[q][j][0] + v[q][j][1] * v[q][j][1]) + (v[q][j][2] * v[q][j][2] + v[q][j][3] * v[q][j][3]); }
            ss[q] = a; }
#pragma unroll
        for (int o = 1; o < 64; o <<= 1) { ss[0] += __shfl_xor(ss[0], o); ss[1] += __shfl_xor(ss[1], o); }
#pragma unroll
        for (int q = 0; q < 2; ++q) { const float rs = rsqrtf(ss[q] * (1.0f / DM) + RMS_EPS); bf16_t* d0 = gx + (size_t)(r0 + q) * DM;
#pragma unroll
            for (int j = 0; j < 8; ++j) { const int k = 256 * j + 4 * F.lane; v[q][j] = v[q][j] * rs * *(const LAS f32x4*)(Av + k) + *(const LAS f32x4*)(Bv + k); *(u32x2*)(d0 + k) = pk4(v[q][j]); } }
        float pl[2][16];
#pragma unroll
        for (int e = 0; e < 16; ++e) { float a0 = 0.f, a1 = 0.f;
#pragma unroll
            for (int j = 0; j < 8; ++j) { const f32x4 w = *(const LAS f32x4*)(wr + e * DM + 256 * j + 4 * F.lane);
                a0 += (v[0][j][0] * w[0] + v[0][j][1] * w[1]) + (v[0][j][2] * w[2] + v[0][j][3] * w[3]); a1 += (v[1][j][0] * w[0] + v[1][j][1] * w[1]) + (v[1][j][2] * w[2] + v[1][j][3] * w[3]); }
            pl[0][e] = a0; pl[1][e] = a1;
            if ((e & 3) == 3) asm volatile("" ::: "memory"); }
        float fin[2];
#pragma unroll
        for (int q = 0; q < 2; ++q) {
            float a8[8], a4[4], a2[2], a1;
            const bool h5 = (F.lane & 32) != 0, h4 = (F.lane & 16) != 0, h3 = (F.lane & 8) != 0, h2 = (F.lane & 4) != 0;
#pragma unroll
            for (int i = 0; i < 8; ++i) { const float keep = h5 ? pl[q][8 + i] : pl[q][i], give = h5 ? pl[q][i] : pl[q][8 + i]; a8[i] = keep + __shfl_xor(give, 32); }
#pragma unroll
            for (int i = 0; i < 4; ++i) { const float keep = h4 ? a8[4 + i] : a8[i], give = h4 ? a8[i] : a8[4 + i]; a4[i] = keep + __shfl_xor(give, 16); }
#pragma unroll
            for (int i = 0; i < 2; ++i) { const float keep = h3 ? a4[2 + i] : a4[i], give = h3 ? a4[i] : a4[2 + i]; a2[i] = keep + __shfl_xor(give, 8); }
            { const float keep = h2 ? a2[1] : a2[0], give = h2 ? a2[0] : a2[1]; a1 = keep + __shfl_xor(give, 4); }
            a1 += __shfl_xor(a1, 1); a1 += __shfl_xor(a1, 2);
            fin[q] = a1;
        }
        const int ex = ((F.lane >> 5) & 1) * 8 + ((F.lane >> 4) & 1) * 4 + ((F.lane >> 3) & 1) * 2 + ((F.lane >> 2) & 1);
#pragma unroll
        for (int q = 0; q < 2; ++q) {
            float mx = fin[q];
#pragma unroll
            for (int o = 4; o < 64; o <<= 1) mx = fmaxf(mx, __shfl_xor(mx, o));
            const float exv = __expf(fin[q] - mx);
            float sum = exv;
#pragma unroll
            for (int o = 4; o < 64; o <<= 1) sum += __shfl_xor(sum, o);
            if ((F.lane & 3) == 0) aff[(size_t)ex * SEQ + r0 + q] = exv / sum;
        }
    }
    __syncthreads();
}

__device__ __forceinline__ int block_excl_scan(int v, LAS int* sc, int tid, int* tot) {
    const int lane = tid & 63, w = tid >> 6;
    int inc = v;
#pragma unroll
    for (int o = 1; o < 64; o <<= 1) { const int t = __shfl_up(inc, o); if (lane >= o) inc += t; }
    __syncthreads();
    if (lane == 63) sc[w] = inc;
    __syncthreads();
    int base = 0, total = 0;
#pragma unroll
    for (int i = 0; i < 8; ++i) { const int s = sc[i]; if (i < w) base += s; total += s; }
    *tot = total;
    return base + inc - v;
}
__device__ __forceinline__ int block_sum(int v, LAS int* sc, int tid, int par) {
#pragma unroll
    for (int o = 1; o < 64; o <<= 1) v += __shfl_xor(v, o);
    if ((tid & 63) == 0) sc[par * 8 + (tid >> 6)] = v;
    __syncthreads();
    int t = 0;
#pragma unroll
    for (int i = 0; i < 8; ++i) t += sc[par * 8 + i];
    return t;
}
__device__ __forceinline__ void p8_select(const Frame& F, const Params& P) {
    if ((int)blockIdx.x >= NE) return;
    unsigned char* ws = P.ws;
    const int e = blockIdx.x, tid = F.tid;
    const float* aff = (const float*)(ws + WS_AFF) + (size_t)e * SEQ;
    int* idx = (int*)(ws + WS_IDX) + e * CAP; float* gate = (float*)(ws + WS_GATE) + e * CAP; int* slot = (int*)(ws + WS_SLOT) + (size_t)e * SEQ;
    LAS int* sc = (LAS int*)F.lds;
    LAS unsigned* buf = (LAS unsigned*)(F.lds + 256);
    LAS unsigned* lidx = buf + 16384 + 512 + 64;
    LAS unsigned* lgate = lidx + CAP;
#pragma unroll
    for (int i = 0; i < 8; ++i) { const int t = (i * NTHREADS + tid) * 4; const u32x4 q = *(const u32x4*)(aff + t);
        buf[t + (t >> 5)] = q.x; buf[t + 1 + ((t + 1) >> 5)] = q.y; buf[t + 2 + ((t + 2) >> 5)] = q.z; buf[t + 3 + ((t + 3) >> 5)] = q.w; }
    __syncthreads();
    unsigned v[32];
#pragma unroll
    for (int j = 0; j < 32; ++j) v[j] = buf[33 * tid + j];
    unsigned T = 0;
#pragma unroll 1
    for (int bit = 30; bit >= 0; --bit) {
        const unsigned cand = T | (1u << bit); int cnt = 0;
#pragma unroll
        for (int j = 0; j < 32; ++j) cnt += __builtin_popcountll(__ballot(v[j] >= cand));
        if ((tid & 63) == 0) sc[(bit & 1) * 8 + (tid >> 6)] = cnt;
        __syncthreads();
        int tot = 0;
#pragma unroll
        for (int i = 0; i < 8; ++i) tot += sc[(bit & 1) * 8 + i];
        if (tot >= CAP) T = cand;
    }
    int cgt = 0, ceq = 0;
#pragma unroll
    for (int j = 0; j < 32; ++j) { cgt += (v[j] > T) ? 1 : 0; ceq += (v[j] == T) ? 1 : 0; }
    __syncthreads();
    const int ngt = block_sum(cgt, sc, tid, 0);
    const int remaining = CAP - ngt;
    int tot; int eqbase = block_excl_scan(ceq, sc + 16, tid, &tot);
    unsigned selmask = 0; int csel = 0;
#pragma unroll
    for (int j = 0; j < 32; ++j) { bool sl = v[j] > T; if (v[j] == T) { sl = eqbase < remaining; ++eqbase; } if (sl) { selmask |= 1u << j; ++csel; } }
    int sbase = block_excl_scan(csel, sc + 16, tid, &tot);
#pragma unroll
    for (int j = 0; j < 32; ++j) { int sl = -1; if ((selmask >> j) & 1u) { sl = sbase++; if (sl < CAP) { lidx[sl] = (unsigned)(32 * tid + j); lgate[sl] = v[j]; } } buf[33 * tid + j] = (unsigned)sl; }
    __syncthreads();
#pragma unroll
    for (int i = 0; i < 8; ++i) { const int t = (i * NTHREADS + tid) * 4; u32x4 q;
        q.x = buf[t + (t >> 5)]; q.y = buf[t + 1 + ((t + 1) >> 5)]; q.z = buf[t + 2 + ((t + 2) >> 5)]; q.w = buf[t + 3 + ((t + 3) >> 5)]; *(u32x4*)(slot + t) = q; }
    { const int t = tid * 4; *(u32x4*)(idx + t) = *(const LAS u32x4*)(lidx + t); *(u32x4*)(gate + t) = *(const LAS u32x4*)(lgate + t); }
    __syncthreads();
}

__device__ __forceinline__ void p8b_gather(const Frame& F, const Params& P) {
    unsigned char* ws = P.ws;
    const bf16_t* gx = (const bf16_t*)(ws + RA_GX); bf16_t* xs = (bf16_t*)(ws + RB_XS); const int* idx = (const int*)(ws + WS_IDX);
    for (int r = F.gw; r < NE * CAP; r += F.NGW) {
        const int t = idx[r];
        const u32x4* s = (const u32x4*)(gx + (size_t)t * DM); u32x4* d = (u32x4*)(xs + (size_t)r * DM);
#pragma unroll
        for (int j = 0; j < 4; ++j) d[64 * j + F.lane] = s[64 * j + F.lane];
    }
}

__device__ __forceinline__ void p11_final(const Frame& F, const Params& P) {
    unsigned char* ws = P.ws;
    const float* modf = (const float*)(ws + WS_MODF); const bf16_t* slab = (const bf16_t*)(ws + RB_SLAB); const int* slot = (const int*)(ws + WS_SLOT);
    LAS float* M2 = (LAS float*)(F.lds + LDS_VEC); LAS float* M5 = M2 + DM; LAS float* NF = M5 + DM;
    {   float a2[4], a5[4], an[4];
#pragma unroll
        for (int i = 0; i < 4; ++i) { const int k = i * NTHREADS + F.tid; a2[i] = modf[2 * DM + k]; a5[i] = modf[5 * DM + k]; an[i] = P.norm_final[k]; }
#pragma unroll
        for (int i = 0; i < 4; ++i) { const int k = i * NTHREADS + F.tid; M2[k] = a2[i]; M5[k] = a5[i]; NF[k] = an[i]; }
    }
    __syncthreads();
    const bf16_t* ox = (const bf16_t*)(ws + RA_OX);
    for (int r0 = 2 * F.gw; r0 < SEQ; r0 += 2 * F.NGW) {
        asm volatile("" ::: "memory");
        f32x4 v[2][8], a[2][8];
        int sl[2];
#pragma unroll
        for (int q = 0; q < 2; ++q) sl[q] = (F.lane < NE) ? slot[(size_t)F.lane * SEQ + r0 + q] : -1;
#pragma unroll
        for (int q = 0; q < 2; ++q) { u32x2 ow[8];
#pragma unroll
            for (int j = 0; j < 8; ++j) { const size_t o = (size_t)(r0 + q) * DM + 256 * j + 4 * F.lane; v[q][j] = *(const f32x4*)(P.x + o); ow[j] = *(const u32x2*)(ox + o); a[q][j] = (f32x4){0.f, 0.f, 0.f, 0.f}; }
#pragma unroll
            for (int j = 0; j < 8; ++j) v[q][j] = v[q][j] + *(const LAS f32x4*)(M2 + 256 * j + 4 * F.lane) * bf4_to_f32(ow[j]); }
        unsigned long long m0 = __ballot(sl[0] >= 0), m1 = __ballot(sl[1] >= 0);
        while (m0 | m1) {
            const int e0 = m0 ? __builtin_ctzll(m0) : 0, e1 = m1 ? __builtin_ctzll(m1) : 0;
            const int s0 = m0 ? __builtin_amdgcn_readlane(sl[0], e0) : 0, s1 = m1 ? __builtin_amdgcn_readlane(sl[1], e1) : 0;
            const float w0 = m0 ? 1.f : 0.f, w1 = m1 ? 1.f : 0.f;
            const bf16_t* ya = slab + (size_t)(e0 * CAP + s0) * DM; const bf16_t* yb = slab + (size_t)(e1 * CAP + s1) * DM;
            u32x2 y0[8], y1[8];
#pragma unroll
            for (int j = 0; j < 8; ++j) { y0[j] = *(const u32x2*)(ya + 256 * j + 4 * F.lane); y1[j] = *(const u32x2*)(yb + 256 * j + 4 * F.lane); }
#pragma unroll
            for (int j = 0; j < 8; ++j) { a[0][j] += bf4_to_f32(y0[j]) * w0; a[1][j] += bf4_to_f32(y1[j]) * w1; }
            m0 &= m0 - 1; m1 &= m1 - 1;
        }
#pragma unroll
        for (int q = 0; q < 2; ++q) {
            float ss = 0.f;
#pragma unroll
            for (int j = 0; j < 8; ++j) { const int k = 256 * j + 4 * F.lane; v[q][j] = v[q][j] + *(const LAS f32x4*)(M5 + k) * a[q][j];
                ss += (v[q][j][0] * v[q][j][0] + v[q][j][1] * v[q][j][1]) + (v[q][j][2] * v[q][j][2] + v[q][j][3] * v[q][j][3]); }
            const float rs = rsqrtf(wave_sum(ss) * (1.0f / DM) + RMS_EPS);
            float* row = P.out + (size_t)(r0 + q) * DM;
#pragma unroll
            for (int j = 0; j < 8; ++j) { const int k = 256 * j + 4 * F.lane; *(f32x4*)(row + k) = v[q][j] * rs * *(const LAS f32x4*)(NF + k); }
        }
    }
}

#define XB_TMO      128
#define XB_XCNT(j)  (256  + 64 * (j))
#define XB_XSUB(j)  (1280 + 64 * (j))
#define XB_XGEN(j)  (2304 + 64 * (j))
#define XB_TOP      3328
#define XB_TOPGEN   3392
#define XCD_BAR_WORDS 3456
#define XB_SPIN_CAP (1u << 18)
__device__ __forceinline__ unsigned xb_ld(unsigned* p)              { return __hip_atomic_load(p, __ATOMIC_RELAXED, __HIP_MEMORY_SCOPE_AGENT); }
__device__ __forceinline__ unsigned xb_add(unsigned* p, unsigned v) { return __hip_atomic_fetch_add(p, v, __ATOMIC_RELAXED, __HIP_MEMORY_SCOPE_AGENT); }
__device__ __forceinline__ unsigned xb_xcc_id() { return (unsigned)__builtin_amdgcn_s_getreg((3 << 11) | 20) & 0xFu; }
#define XB_SPIN(cond, bar) do { unsigned _sp = 0; while (cond) { __builtin_amdgcn_s_sleep(1); \
    if ((++_sp & 255u) == 0u) { if (xb_ld(&(bar)[XB_TMO])) break; if (_sp > XB_SPIN_CAP) { atomicAdd(&(bar)[XB_TMO], 1u); break; } } } } while (0)
struct XcdBarrier { unsigned* bar; unsigned x; volatile LAS unsigned* st; };
__device__ __forceinline__ XcdBarrier xcd_barrier_post(unsigned* bar, volatile LAS unsigned* st) {
    XcdBarrier b; b.bar = bar; b.x = xb_xcc_id(); b.st = st;
    if (threadIdx.x == 0) (void)xb_add(&bar[XB_XCNT(b.x)], 1u);
    return b;
}
__device__ __forceinline__ void xcd_barrier_complete(unsigned* bar, unsigned x, unsigned& nloc, unsigned& nx) {
    const unsigned G = gridDim.x * gridDim.y * gridDim.z;
    unsigned sum, cnt, mine, sp = 0u;
    for (;;) {
        sum = 0u; cnt = 0u; mine = 0u;
#pragma unroll
        for (unsigned j = 0; j < 16; ++j) { const unsigned c = xb_ld(&bar[XB_XCNT(j)]); sum += c; cnt += (c > 0u) ? 1u : 0u; mine = (j == x) ? c : mine; }
        if (sum == G) break;
        __builtin_amdgcn_s_sleep(1);
        if ((++sp & 255u) == 0u) { if (xb_ld(&bar[XB_TMO])) break; if (sp > XB_SPIN_CAP) { atomicAdd(&bar[XB_TMO], 1u); break; } }
    }
    nloc = mine > 0u ? mine : 1u; nx = cnt > 0u ? cnt : 1u;
}
__device__ __forceinline__ void xcd_barrier(const XcdBarrier& b) {
    asm volatile("s_waitcnt vmcnt(0)" ::: "memory");
    __syncthreads();
    if (threadIdx.x == 0) {
        unsigned* bar = b.bar;
        __builtin_amdgcn_s_waitcnt(0);
        unsigned nloc = b.st[0], nx = b.st[1];
        if (nloc == 0u) { xcd_barrier_complete(bar, b.x, nloc, nx); b.st[0] = nloc; b.st[1] = nx; }
        const unsigned old = xb_add(&bar[XB_XSUB(b.x)], 1u);
        const unsigned gen = old / nloc;
        if (old + 1u == (gen + 1u) * nloc) {
            __builtin_amdgcn_fence(__ATOMIC_RELEASE, "agent");
            asm volatile("s_waitcnt vmcnt(0)" ::: "memory");
            const unsigned og = xb_add(&bar[XB_TOP], 1u);
            const unsigned tg = og / nx;
            if (og + 1u == (tg + 1u) * nx) xb_add(&bar[XB_TOPGEN], 1u);
            else XB_SPIN(xb_ld(&bar[XB_TOPGEN]) == tg, bar);
            __builtin_amdgcn_fence(__ATOMIC_ACQUIRE, "agent");
            xb_add(&bar[XB_XGEN(b.x)], 1u);
            asm volatile("s_waitcnt vmcnt(0)" ::: "memory");
        } else {
            XB_SPIN(xb_ld(&bar[XB_XGEN(b.x)]) == gen, bar);
            __builtin_amdgcn_fence(__ATOMIC_ACQUIRE, "agent");
            asm volatile("s_waitcnt vmcnt(0)" ::: "memory");
        }
    }
    __syncthreads();
}
constexpr int MISC_OFF = 131072 + 320;

#if SELF_CHECK
#include "selfcheck.inc"
#endif
__global__ void __launch_bounds__(NTHREADS, 2) mega_fwd(Params P) {
    extern __shared__ __attribute__((aligned(16))) unsigned char lds_raw[];
    cg::grid_group grid = cg::this_grid();
    Frame F;
    F.lds = (LAS unsigned char*)lds_raw;
    F.tid = threadIdx.x; F.lane = F.tid & 63; F.wave = __builtin_amdgcn_readfirstlane(F.tid >> 6);
    F.G = gridDim.x; { const int bx = blockIdx.x; F.vcu = (F.G % 8 == 0) ? (bx % 8) * (F.G / 8) + bx / 8 : bx; }
    F.gw = F.vcu * NWAVES + F.wave; F.NGW = F.G * NWAVES;
    unsigned char* ws = P.ws;
    const int bid = blockIdx.x, G = F.G;
    for (int u = F.tid; u < 2048 / 4; u += NTHREADS) ((LAS unsigned*)(F.lds + LDS_CTL))[u] = 0u;
    __syncthreads();
    const XcdBarrier xbar = xcd_barrier_post((unsigned*)(ws + WS_CTL) + 4096, (volatile LAS unsigned*)(F.lds + MISC_OFF) + 8);
    bf16_t* hn = (bf16_t*)(ws + RA_HN); bf16_t* hp = (bf16_t*)(ws + RA_HP); bf16_t* wint = (bf16_t*)(ws + WS_WINT);
    bf16_t* Q = (bf16_t*)(ws + RB_Q); bf16_t* Kb = (bf16_t*)(ws + RB_K); bf16_t* Vt = (bf16_t*)(ws + RB_VT); bf16_t* Ux = (bf16_t*)(ws + RB_UX);
    bf16_t* Tb = (bf16_t*)(ws + RA_T); bf16_t* PQ = (bf16_t*)(ws + RA_PQ); bf16_t* mix = (bf16_t*)(ws + WS_RC);
    bf16_t* xs = (bf16_t*)(ws + RB_XS); bf16_t* hmid = (bf16_t*)(ws + RA_HMID); bf16_t* slab = (bf16_t*)(ws + RB_SLAB);
#define REFRESH() do { int t_ = threadIdx.x; asm volatile("" : "+v"(t_)); F.tid = t_; F.lane = t_ & 63; F.wave = __builtin_amdgcn_readfirstlane(t_ >> 6); F.gw = F.vcu * NWAVES + F.wave; } while (0)
#if SELF_CHECK
#define CHECK(n) do { selfcheck_##n(F, P); xcd_barrier(xbar); } while (0)
#else
#define CHECK(n) do { } while (0)
#endif

    for (int rep = 0; rep < REP_P0; ++rep) { p0_prep(F, P); __syncthreads(); }
    grid.sync(); REFRESH();
    for (int rep = 0; rep < REP_P1; ++rep) { p1_norm(F, P); __syncthreads(); }
    xcd_barrier(xbar); REFRESH();
    CHECK(1);
    for (int rep = 0; rep < REP_P2; ++rep) { SchedP2 S{hn, hp, wint, G, bid}; EpiP2 E{Q, Kb, Vt, Ux, (const float*)(ws + WS_ROPEC), (const float*)(ws + WS_ROPES)};
      pg8::gemm_phase(F.lds, DM, DM, DM, S, E); }
    xcd_barrier(xbar); REFRESH();
    CHECK(2);
    for (int rep = 0; rep < REP_P3A; ++rep) for (int it = F.vcu; it < 512; it += G) attn_item(F, it, Q, Kb, Vt, mix, P.sink);
    for (int rep = 0; rep < REP_P3B; ++rep) { SchedSimple S{(const char*)(ws + WS_F1), (const char*)Ux, 1, 512, 1, G, bid, 0, (size_t)256 * 128 * 2, 0, 0}; EpiFFT1 E{Tb, (const float*)(ws + WS_TWC), (const float*)(ws + WS_TWS)};
      int kk; asm volatile("s_mov_b32 %0, 128" : "=s"(kk));
      pg8::gemm_phase(F.lds, kk, 128, 128, S, E); }
    xcd_barrier(xbar); REFRESH();
    CHECK(3);
    for (int rep = 0; rep < REP_P4; ++rep) { SchedSimple S{(const char*)(ws + WS_G2), (const char*)Tb, 1, 512, 1, G, bid, 0, (size_t)256 * 256 * 2, 0, 0}; EpiFFT2 E{PQ};
      pg8::gemm_phase(F.lds, 256, 256, 256, S, E); }
    xcd_barrier(xbar); REFRESH();
    CHECK(4);
    for (int rep = 0; rep < REP_P5; ++rep) { SchedSimple S{(const char*)PQ, (const char*)(ws + WS_MGT), 64, 1, 4, G, bid, (size_t)256 * DM * 2, 0, (size_t)512 * 2, (size_t)256 * 512 * 2}; EpiFMIX E{mix};
      pg8::gemm_phase(F.lds, 512, DM, 512, S, E); }
    xcd_barrier(xbar); REFRESH();
    CHECK(5);
    for (int rep = 0; rep < REP_P6; ++rep) { SchedSimple S{(const char*)mix, (const char*)(ws + WS_WOT), 64, 8, 1, G, bid, (size_t)256 * DM * 2, (size_t)256 * DM * 2, 0, 0}; EpiOUT E{(bf16_t*)(ws + RA_OX)};
      pg8::gemm_phase(F.lds, DM, DM, DM, S, E); }
    xcd_barrier(xbar); REFRESH();
    CHECK(6);
    for (int rep = 0; rep < REP_P7; ++rep) p7_router(F, P);
    xcd_barrier(xbar); REFRESH();
    CHECK(7);
    for (int rep = 0; rep < REP_P8; ++rep) { p8_select(F, P); __syncthreads(); }
    xcd_barrier(xbar); REFRESH();
    CHECK(8);
    for (int rep = 0; rep < REP_P9; ++rep) { SchedUP S{(const char*)(ws + RA_GX), (const char*)(ws + WS_WGU), (const int*)(ws + WS_IDX), G, bid}; EpiUP E{hmid};
      pg8::gemm_phase<EpiUP, SchedUP, true>(F.lds, DM, DM, DM, S, E); }
    xcd_barrier(xbar); REFRESH();
    CHECK(9);
    for (int rep = 0; rep < REP_P10; ++rep) { SchedSimple S{(const char*)hmid, (const char*)(ws + WS_WD), 8, 8, 16, G, bid, (size_t)256 * FF * 2, (size_t)256 * FF * 2, (size_t)CAP * FF * 2, (size_t)DM * FF * 2}; EpiDOWN E{slab, (const float*)(ws + WS_GATE)};
      pg8::gemm_phase(F.lds, FF, FF, FF, S, E); }
    xcd_barrier(xbar); REFRESH();
    CHECK(10);
    for (int rep = 1; rep < REP_BAR; ++rep) xcd_barrier(xbar);
    p11_final(F, P);
#if SELF_CHECK
    xcd_barrier(xbar); REFRESH();
    selfcheck_report(F, P);
#endif
}

extern "C" void kernel_launch(void* const* d_in, const int* in_sizes, int n_in, void* d_out, int out_size, void* d_ws, size_t ws_size, hipStream_t stream) {
    static int grid = 0;
    if (grid == 0) {
        if (n_in != 17 || out_size != SEQ * DM || ws_size < WS_END) { fprintf(stderr, "kernel_launch: unexpected shapes (n_in %d out %d ws %zu)\n", n_in, out_size, ws_size); grid = -1; return; }
        int dev = 0, cus = 0, per_cu = 0;
        hipGetDevice(&dev); hipDeviceGetAttribute(&cus, hipDeviceAttributeMultiprocessorCount, dev);
        if (hipFuncSetAttribute((const void*)mega_fwd, hipFuncAttributeMaxDynamicSharedMemorySize, LDS_BYTES) != hipSuccess) { fprintf(stderr, "kernel_launch: hipFuncSetAttribute failed\n"); grid = -1; return; }
        if (hipOccupancyMaxActiveBlocksPerMultiprocessor(&per_cu, (const void*)mega_fwd, NTHREADS, LDS_BYTES) != hipSuccess || per_cu < 1) { fprintf(stderr, "kernel_launch: occupancy query says %d\n", per_cu); per_cu = 1; }
        (void)hipGetLastError();
        grid = cus;
    }
    if (grid < 0) return;
    hipMemsetAsync((char*)d_ws + WS_CTL, 0, CTL_BYTES, stream);
    Params p{};
    p.x = (const float*)d_in[0]; p.c = (const float*)d_in[1]; p.ctx = (const float*)d_in[2]; p.c_ctx = (const float*)d_in[3]; p.w_mod = (const float*)d_in[4]; p.b_mod = (const float*)d_in[5];
    p.norm_mix = (const float*)d_in[6]; p.w_in = (const float*)d_in[7]; p.sink = (const float*)d_in[8]; p.w_f = (const float*)d_in[9]; p.w_out = (const float*)d_in[10]; p.norm_ffn = (const float*)d_in[11];
    p.w_router = (const float*)d_in[12]; p.w_gate = (const float*)d_in[13]; p.w_up = (const float*)d_in[14]; p.w_down = (const float*)d_in[15]; p.norm_final = (const float*)d_in[16];
    p.out = (float*)d_out; p.ws = (unsigned char*)d_ws;
    void* args[] = {&p};
    hipError_t e = hipLaunchCooperativeKernel((const void*)mega_fwd, dim3(grid), dim3(NTHREADS), args, LDS_BYTES, stream);
    if (e != hipSuccess) fprintf(stderr, "kernel_launch: cooperative launch failed: %s (grid %d)\n", hipGetErrorString(e), grid);
}
```
